# Optimizing an MI355X kernel written in HIP

```python
import jax, jax.numpy as jnp
from jax import lax
import numpy as np

D_MODEL = 2048
BATCH = 4
SEQ = 2048
DEPTH = 4

CHUNK = 64
EPS = 1e-6
RET_HEADS = 8
RET_DK = 256
RET_DV = 256
RET_W = RET_HEADS * RET_DV
ROT_BASE = 10000.0
ATT_HEADS = 16
ATT_DH = 128
ATT_W = ATT_HEADS * ATT_DH
IDX_HEADS = 16
IDX_DH = 64
INDEX_TOPK = 256
Q_BLOCK = 128

SPLIT_SIZES = (RET_HEADS * RET_DK, RET_HEADS * RET_DK, RET_W, RET_W,
               ATT_W, ATT_DH, ATT_DH, ATT_W,
               IDX_HEADS * IDX_DH, IDX_DH, IDX_HEADS,
               D_MODEL, D_MODEL)
N_IN = sum(SPLIT_SIZES)

kernel_name = "hybrid_retention_dsa_gated_trunk"


def rmsnorm(x, g):
    xf = x.astype(jnp.float32)
    r = lax.rsqrt(jnp.mean(xf * xf, axis=-1, keepdims=True) + EPS)
    return (xf * r * g.astype(jnp.float32)).astype(x.dtype)


def rotate(x, cos, sin):
    half = x.shape[-1] // 2
    x1, x2 = x[..., :half], x[..., half:]
    return jnp.concatenate([x1 * cos - x2 * sin, x2 * cos + x1 * sin], axis=-1)


def retention(q, k, v):
    B, S, H, DK = q.shape
    DV = v.shape[-1]
    dt = q.dtype
    nc = S // CHUNK
    pos = jnp.arange(S, dtype=jnp.float32)
    inv = 1.0 / (ROT_BASE ** jnp.linspace(0.0, 1.0, DK // 2, dtype=jnp.float32))
    ang = pos[:, None] * inv[None, :]
    cos = jnp.cos(ang)[None, :, None, :].astype(dt)
    sin = jnp.sin(ang)[None, :, None, :].astype(dt)
    q = rotate(q, cos, sin)
    k = rotate(k, cos, sin) * jnp.asarray(DK ** -0.5, dt)
    log_g = jnp.log(1.0 - 2.0 ** (-5.0 - jnp.arange(H, dtype=jnp.float32)))
    idx = jnp.arange(CHUNK, dtype=jnp.float32)
    intra = jnp.exp(jnp.abs(idx[:, None] - idx[None, :])[None] * log_g[:, None, None]).astype(dt)
    q_dec = jnp.exp((idx[:, None] + 1.0) * log_g[None, :]).astype(dt)
    k_dec = jnp.exp((CHUNK - 1.0 - idx[:, None]) * log_g[None, :]).astype(dt)
    c_dec = jnp.exp(CHUNK * log_g).astype(dt)

    def to_chunks(a):
        return a.reshape(B, nc, CHUNK, H, a.shape[-1]).transpose(1, 0, 2, 3, 4)

    def step(state, inp):
        qc, kc, vc = inp
        s = jnp.einsum('bihd,bjhd->bhij', qc, kc) * intra[None]
        o = jnp.einsum('bhij,bjhv->bihv', s, vc)
        o = o + jnp.einsum('bihd,bhdv->bihv', qc, state) * q_dec[None, :, :, None]
        state = state * c_dec[None, :, None, None] + jnp.einsum(
            'bjhd,bjhv->bhdv', kc * k_dec[None, :, :, None], vc)
        return state, o

    state0 = jnp.zeros((B, H, DK, DV), dt)
    _, o = lax.scan(step, state0, (to_chunks(q), to_chunks(k), to_chunks(v)))
    return o.transpose(1, 0, 2, 3, 4).reshape(B, S, H, DV)


def sparse_attention(q, k, v, qi, ki, wi):
    B, S, HA, DH = q.shape
    L = k.shape[1]
    topk = min(INDEX_TOPK, L // 4)
    nb = S // Q_BLOCK
    key_chunk = jnp.arange(L) // CHUNK
    idx_scale = IDX_DH ** -0.5
    att_scale = DH ** -0.5

    def blocks(a):
        return a.reshape((B, nb, Q_BLOCK) + a.shape[2:]).swapaxes(0, 1)

    def one_block(args):
        qb, qib, wib, tb = args
        sc = jax.nn.relu(jnp.einsum('bthd,bsd->btsh', qib, ki))
        score = jnp.einsum('btsh,bth->bts', sc, wib).astype(jnp.float32) * idx_scale
        adm = key_chunk[None, :] <= (tb // CHUNK)[:, None]
        score = jnp.where(adm[None], score, -jnp.inf)
        vals, sel = lax.top_k(score, topk)
        valid = jnp.isfinite(vals)
        ks = jax.vmap(lambda a, i: a[i])(k, sel)
        vs = jax.vmap(lambda a, i: a[i])(v, sel)
        logits = jnp.einsum('bthd,btkd->bhtk', qb, ks).astype(jnp.float32) * att_scale
        logits = jnp.where(valid[:, None], logits, -jnp.inf)
        p = jax.nn.softmax(logits, axis=-1).astype(vs.dtype)
        return jnp.einsum('bhtk,btkd->bthd', p, vs)

    tpos = jnp.arange(S, dtype=jnp.int32).reshape(nb, Q_BLOCK)
    o = lax.map(one_block, (blocks(q), blocks(qi), blocks(wi), tpos))
    return o.swapaxes(0, 1).reshape(B, S, HA, DH)


def setup_inputs(seed: int = 0) -> dict:
    key = jax.random.key(seed)
    ks = jax.random.split(key, 10)
    f32 = jnp.float32
    x = jax.random.normal(ks[0], (BATCH, SEQ, D_MODEL), f32)
    norm_g = 1.0 + 0.02 * jax.random.normal(ks[1], (DEPTH, D_MODEL), f32)
    w_in = jax.random.normal(ks[2], (DEPTH, D_MODEL, N_IN), f32) * D_MODEL ** -0.5
    ret_out_g = 1.0 + 0.02 * jax.random.normal(ks[3], (DEPTH, RET_HEADS, RET_DV), f32)
    att_q_g = 1.0 + 0.02 * jax.random.normal(ks[4], (DEPTH, ATT_DH), f32)
    att_k_g = 1.0 + 0.02 * jax.random.normal(ks[5], (DEPTH, ATT_DH), f32)
    idx_k_g = 1.0 + 0.02 * jax.random.normal(ks[6], (DEPTH, IDX_DH), f32)
    w_branch_ret = jax.random.normal(ks[7], (DEPTH, RET_W, D_MODEL), f32) * RET_W ** -0.5
    w_branch_att = jax.random.normal(ks[8], (DEPTH, ATT_W, D_MODEL), f32) * ATT_W ** -0.5
    w_out = jax.random.normal(ks[9], (DEPTH, D_MODEL, D_MODEL), f32) * D_MODEL ** -0.5
    return {"x": x, "norm_g": norm_g, "w_in": w_in, "ret_out_g": ret_out_g,
            "att_q_g": att_q_g, "att_k_g": att_k_g, "idx_k_g": idx_k_g,
            "w_branch_ret": w_branch_ret, "w_branch_att": w_branch_att, "w_out": w_out}


def reference(x, norm_g, w_in, ret_out_g, att_q_g, att_k_g, idx_k_g,
              w_branch_ret, w_branch_att, w_out):
    B, S, _ = x.shape
    offsets = []
    acc = 0
    for sz in SPLIT_SIZES[:-1]:
        acc += sz
        offsets.append(acc)
    for l in range(DEPTH):
        h = rmsnorm(x, norm_g[l])
        p = h @ w_in[l]
        (rq, rk, rv, rg, aq, ak, av, ag, iq, ik, iw, ga, gb) = jnp.split(p, offsets, axis=-1)
        ro = retention(rq.reshape(B, S, RET_HEADS, RET_DK),
                       rk.reshape(B, S, RET_HEADS, RET_DK),
                       rv.reshape(B, S, RET_HEADS, RET_DV))
        ro = rmsnorm(ro, ret_out_g[l]).reshape(B, S, RET_W)
        u_ret = (ro * jax.nn.silu(rg)) @ w_branch_ret[l]
        qa = rmsnorm(aq.reshape(B, S, ATT_HEADS, ATT_DH), att_q_g[l])
        ka = rmsnorm(ak, att_k_g[l])
        ao = sparse_attention(qa, ka, av,
                              iq.reshape(B, S, IDX_HEADS, IDX_DH),
                              rmsnorm(ik, idx_k_g[l]),
                              iw * jnp.asarray(IDX_HEADS ** -0.5, iw.dtype))
        u_att = (ao.reshape(B, S, ATT_W) * jax.nn.silu(ag)) @ w_branch_att[l]
        m = jax.nn.sigmoid(ga) * u_ret + jax.nn.sigmoid(gb) * u_att
        x = x + m @ w_out[l]
    return x
```

```cpp
#include <hip/hip_runtime.h>
#include <cstdio>
#include <cstdint>
namespace pg8 {
#define PG8_LAS __attribute__((address_space(3)))
typedef unsigned short bf16_t;
typedef short bf16x8 __attribute__((ext_vector_type(8)));
typedef float f32x4 __attribute__((ext_vector_type(4)));
typedef unsigned u32x4 __attribute__((ext_vector_type(4)));
constexpr int BM = 256, BK = 64, HALF = 128, HTB = HALF * BK * 2  , STAGE_BYTES = 8 * HTB, NXCD = 8, WGM = 8;

__host__ __device__ __forceinline__ int lds_byte(int r, int c) { const int st = (r >> 4) * 2 + (c >> 5), rr = r & 15, cc = c & 31, ob = rr * 64 + cc * 2; return st * 1024 + (ob ^ (((ob >> 9) & 1) << 5)); }
__host__ __device__ __forceinline__ void stage_rc(int b, int& R, int& C) { const int st = b / 1024, sb = b % 1024, swz = sb ^ (((sb >> 9) & 1) << 5); R = (st >> 1) * 16 + swz / 64; C = (st & 1) * 32 + (swz % 64) / 2; }
__host__ __device__ __forceinline__ int perm32(int rho) { const int n = rho >> 4, i = rho & 15; return 8 * (i >> 2) + 4 * n + (i & 3); }

struct Unit { int pm, pn; };
struct Gemm { const bf16_t* A; const bf16_t* Bt; int M, N, K; };

struct StaticOrder {
    int nM, nN, nwg, G, c;
    __host__ __device__ void init(int M, int N, int G_, int c_) { nM = M / BM; nN = N / BM; nwg = nM * nN; G = G_; c = c_; }
    __host__ __device__ bool next(int i, Unit& u) const {
        const long L = (long)i * G + c; if (L >= nwg) return false;
        int wgid = (int)L; { const int q = nwg / NXCD, r = nwg % NXCD, xcd = wgid % NXCD, off = wgid / NXCD; wgid = (xcd < r ? xcd * (q + 1) : r * (q + 1) + (xcd - r) * q) + off; }
        const int nig = WGM * nN, gid = wgid / nig, fm = gid * WGM, gsz = (nM - fm) < WGM ? (nM - fm) : WGM;
        u.pm = fm + ((wgid % nig) % gsz); u.pn = (wgid % nig) / gsz; return true;
    }
    __device__ __forceinline__ void a_ready(const Unit&) const {}
    __device__ __forceinline__ void done(const Unit&) const {}
};

__device__ __forceinline__ unsigned cvt_pk_bf16(float lo, float hi) { unsigned r; asm volatile("v_cvt_pk_bf16_f32 %0, %1, %2" : "=v"(r) : "v"(lo), "v"(hi)); return r; }
template <class Epi, class Sched, bool ALIGN_EPI = false, bool SP2 = false>
__device__ __forceinline__ void gemm_phase(PG8_LAS unsigned char* lds, const Gemm g, const Sched& S, const Epi& E) {
    int tid_ = threadIdx.x; asm volatile("" : "+v"(tid_));
    const int tid = tid_, wid = __builtin_amdgcn_readfirstlane(tid >> 6), lane = tid & 63, wr = wid >> 2, wc = wid & 3, fr = lane & 15, fq = lane >> 4;
    const int K = g.K, nt = K / BK;
    unsigned voffA[2], voffB[2];
#pragma unroll
    for (int i = 0; i < 2; ++i) { int R, C; stage_rc(tid * 16 + i * 8192, R, C); const int Rb = Epi::PERM ? ((R & ~31) + perm32(R & 31)) : R;
        voffA[i] = (unsigned)(R * K + C) * 2u; voffB[i] = (unsigned)(Rb * K + C) * 2u; }
    const size_t kstep = (size_t)(BK * 2);
    const size_t hstep = (size_t)HALF * K * 2;
    const size_t tstep = 2 * hstep;
    const unsigned ldsw = (unsigned)wid * 1024u;
    const int aoff = lds_byte(wr * 64 + fr, fq * 8), boff = lds_byte(wc * 32 + fr, fq * 8);
#define PG8_SA(b, h) (((b) * 2 + (h)) * HTB)
#define PG8_SB(b, h) ((4 + (b) * 2 + (h)) * HTB)
#define PG8_STAGE(bufoff, gbase, voff) do { _Pragma("unroll") for (int _i = 0; _i < 2; ++_i) \
        __builtin_amdgcn_global_load_lds((const unsigned*)((const char*)(gbase) + (voff)[_i]), (PG8_LAS unsigned*)(lds + (bufoff) + ldsw + _i * 8192), 16, 0, 0); } while (0)
#define PG8_LDA(dst, b, h) do { _Pragma("unroll") for (int m = 0; m < 4; ++m) _Pragma("unroll") for (int k = 0; k < 2; ++k) dst[m][k] = *(const PG8_LAS bf16x8*)(lds + PG8_SA(b, h) + aoff + m * 2048 + k * 1024); } while (0)
#define PG8_LDB(dst, b, h) do { _Pragma("unroll") for (int n = 0; n < 2; ++n) _Pragma("unroll") for (int k = 0; k < 2; ++k) dst[n][k] = *(const PG8_LAS bf16x8*)(lds + PG8_SB(b, h) + boff + n * 2048 + k * 1024); } while (0)
#define PG8_MMA(ai, bj, At, Bt) do { __builtin_amdgcn_s_setprio(1); _Pragma("unroll") for (int m = 0; m < 4; ++m) _Pragma("unroll") for (int n = 0; n < 2; ++n) _Pragma("unroll") for (int k = 0; k < 2; ++k) \
        acc[ai][bj][m][n] = __builtin_amdgcn_mfma_f32_16x16x32_bf16(Bt[n][k], At[m][k], acc[ai][bj][m][n], 0, 0, 0); __builtin_amdgcn_s_setprio(0); } while (0)
#define PG8_WAIT_V(n) asm volatile("s_waitcnt vmcnt(" #n ")" ::: "memory")
#define PG8_WAIT_L(n) asm volatile("s_waitcnt lgkmcnt(" #n ")" ::: "memory")
#define PG8_BAR __builtin_amdgcn_s_barrier()
#define PG8_SCHED __builtin_amdgcn_sched_barrier(0)
    Unit cur, nxt; int ui = 0;
    if (!S.next(0, cur)) return;
    f32x4 acc[2][2][4][2];
#pragma unroll
    for (int a = 0; a < 2; ++a)
#pragma unroll
        for (int b = 0; b < 2; ++b)
#pragma unroll
            for (int m = 0; m < 4; ++m)
#pragma unroll
                for (int n = 0; n < 2; ++n) acc[a][b][m][n] = (f32x4){0.f, 0.f, 0.f, 0.f};
    bf16x8 At[4][2], B0[2][2], B1[2][2];
    const char* cA = (const char*)g.A + (size_t)cur.pm * tstep; const char* cB = (const char*)g.Bt + (size_t)cur.pn * tstep;
    S.a_ready(cur);
    if constexpr (SP2) {
        PG8_STAGE(PG8_SB(0, 0), cB, voffB); PG8_STAGE(PG8_SB(0, 1), cB + hstep, voffB); PG8_STAGE(PG8_SA(0, 0), cA, voffA); PG8_STAGE(PG8_SA(0, 1), cA + hstep, voffA);
        if (wr == 1) PG8_BAR;
        PG8_WAIT_V(2); PG8_BAR;
        PG8_STAGE(PG8_SB(1, 0), cB + kstep, voffB); PG8_STAGE(PG8_SA(1, 0), cA + kstep, voffA); PG8_STAGE(PG8_SB(1, 1), cB + hstep + kstep, voffB);
        PG8_WAIT_V(6); PG8_BAR;
    } else {
        PG8_STAGE(PG8_SB(0, 0), cB, voffB); PG8_STAGE(PG8_SA(0, 0), cA, voffA); PG8_STAGE(PG8_SB(0, 1), cB + hstep, voffB); PG8_STAGE(PG8_SA(0, 1), cA + hstep, voffA);
        if (wr == 1) PG8_BAR;
        PG8_WAIT_V(4); PG8_BAR;
        PG8_STAGE(PG8_SB(1, 0), cB + kstep, voffB); PG8_STAGE(PG8_SA(1, 0), cA + kstep, voffA); PG8_STAGE(PG8_SB(1, 1), cB + hstep + kstep, voffB);
        PG8_WAIT_V(6); PG8_BAR;
    }
    for (;;) {
        const bool has_next = S.next(ui + 1, nxt);
        const char* nA = has_next ? (const char*)g.A + (size_t)nxt.pm * tstep : cA; const char* nB = has_next ? (const char*)g.Bt + (size_t)nxt.pn * tstep : cB;
        for (int t = 0; t < nt; t += 2) {
            const bool last = (t == nt - 2);
            const char* a1 = cA + (size_t)(t + 1) * kstep;
            const char* a2 = last ? nA : cA + (size_t)(t + 2) * kstep; const char* b2 = last ? nB : cB + (size_t)(t + 2) * kstep;
            const char* a3 = a2 + kstep; const char* b3 = b2 + kstep;
            if (last && has_next) S.a_ready(nxt);
            if constexpr (SP2) {
            PG8_LDB(B0, 0, 0); PG8_LDB(B1, 0, 1); PG8_SCHED; PG8_LDA(At, 0, 0); PG8_STAGE(PG8_SA(1, 1), a1 + hstep, voffA);
            PG8_WAIT_V(8); PG8_WAIT_L(0); PG8_BAR; PG8_MMA(0, 0, At, B0); PG8_MMA(0, 1, At, B1); PG8_BAR; PG8_SCHED;
            PG8_LDA(At, 0, 1); PG8_STAGE(PG8_SB(0, 0), b2, voffB); PG8_STAGE(PG8_SB(0, 1), b2 + hstep, voffB); PG8_STAGE(PG8_SA(0, 0), a2, voffA);
            PG8_WAIT_V(8); PG8_WAIT_L(0); PG8_BAR; PG8_MMA(1, 0, At, B0); PG8_MMA(1, 1, At, B1); PG8_BAR; PG8_SCHED;
            PG8_LDB(B0, 1, 0); PG8_LDB(B1, 1, 1); PG8_SCHED; PG8_LDA(At, 1, 0); PG8_STAGE(PG8_SA(0, 1), a2 + hstep, voffA);
            PG8_WAIT_V(8); PG8_WAIT_L(0); PG8_BAR; PG8_MMA(0, 0, At, B0); PG8_MMA(0, 1, At, B1); PG8_BAR; PG8_SCHED;
            PG8_LDA(At, 1, 1); PG8_STAGE(PG8_SB(1, 0), b3, voffB); PG8_STAGE(PG8_SB(1, 1), b3 + hstep, voffB); PG8_STAGE(PG8_SA(1, 0), a3, voffA);
            PG8_WAIT_V(8); PG8_WAIT_L(0); PG8_BAR; PG8_MMA(1, 0, At, B0); PG8_MMA(1, 1, At, B1); PG8_BAR; PG8_SCHED;
            } else {
            PG8_LDB(B0, 0, 0); PG8_SCHED; PG8_LDA(At, 0, 0); PG8_STAGE(PG8_SA(1, 1), a1 + hstep, voffA);
            PG8_WAIT_L(8); PG8_BAR; PG8_WAIT_L(0); PG8_MMA(0, 0, At, B0); PG8_BAR; PG8_SCHED;
            PG8_LDB(B1, 0, 1); PG8_STAGE(PG8_SB(0, 0), b2, voffB);
            PG8_BAR; PG8_WAIT_L(0); PG8_MMA(0, 1, At, B1); PG8_BAR;
            PG8_LDA(At, 0, 1); PG8_STAGE(PG8_SA(0, 0), a2, voffA);
            PG8_BAR; PG8_WAIT_L(0); PG8_MMA(1, 0, At, B0); PG8_BAR; PG8_SCHED;
            PG8_STAGE(PG8_SB(0, 1), b2 + hstep, voffB);
            PG8_WAIT_V(6); PG8_BAR; PG8_MMA(1, 1, At, B1); PG8_BAR;
            PG8_LDB(B0, 1, 0); PG8_SCHED; PG8_LDA(At, 1, 0); PG8_STAGE(PG8_SA(0, 1), a2 + hstep, voffA);
            PG8_WAIT_L(8); PG8_BAR; PG8_WAIT_L(0); PG8_MMA(0, 0, At, B0); PG8_BAR; PG8_SCHED;
            PG8_LDB(B1, 1, 1); PG8_STAGE(PG8_SB(1, 0), b3, voffB);
            PG8_BAR; PG8_WAIT_L(0); PG8_MMA(0, 1, At, B1); PG8_BAR;
            PG8_LDA(At, 1, 1); PG8_STAGE(PG8_SA(1, 0), a3, voffA);
            PG8_BAR; PG8_WAIT_L(0); PG8_MMA(1, 0, At, B0); PG8_BAR; PG8_SCHED;
            PG8_STAGE(PG8_SB(1, 1), b3 + hstep, voffB);
            PG8_WAIT_V(6); PG8_BAR; PG8_MMA(1, 1, At, B1); PG8_BAR;
            }
        }
        if constexpr (ALIGN_EPI) { if (wr == 0) PG8_BAR; }
        if constexpr (!Epi::AFTER_DRAIN) { E(acc, cur, wr, wc, fr, fq); S.done(cur); }
        if (!has_next) break;
#pragma unroll
        for (int a = 0; a < 2; ++a)
#pragma unroll
            for (int b = 0; b < 2; ++b)
#pragma unroll
                for (int m = 0; m < 4; ++m)
#pragma unroll
                    for (int n = 0; n < 2; ++n) acc[a][b][m][n] = (f32x4){0.f, 0.f, 0.f, 0.f};
        cur = nxt; cA = nA; cB = nB; ++ui;
        if constexpr (ALIGN_EPI) { if (wr == 1) PG8_BAR; }
    }
    PG8_WAIT_V(0);
    if constexpr (!ALIGN_EPI) { if (wr == 0) PG8_BAR; }
    PG8_BAR;
    if constexpr (Epi::AFTER_DRAIN) { E.fused(acc, cur, wr, wc, fr, fq, lds, wid, lane); S.done(cur); }
#undef PG8_SA
#undef PG8_SB
#undef PG8_STAGE
#undef PG8_LDA
#undef PG8_LDB
#undef PG8_MMA
#undef PG8_WAIT_V
#undef PG8_WAIT_L
#undef PG8_BAR
#undef PG8_SCHED
}
}
#include <hip/hip_cooperative_groups.h>
namespace cg = cooperative_groups;
#define LAS __attribute__((address_space(3)))
#define GAS __attribute__((address_space(1)))
typedef unsigned short bf16;
typedef short bf16x8 __attribute__((ext_vector_type(8)));
typedef short s16x4 __attribute__((ext_vector_type(4)));
typedef float f32x4 __attribute__((ext_vector_type(4)));
typedef unsigned u32x4 __attribute__((ext_vector_type(4)));
typedef unsigned u32x2 __attribute__((ext_vector_type(2)));

constexpr int DM = 2048, NBATCH = 4, SEQ = 2048, NTOK = NBATCH * SEQ, DEPTH = 4;
constexpr int NSRC = 17744, NP = 17920;
constexpr int C_RQ = 0, C_RK = 2048, C_RV = 4096, C_RG = 6144, C_AQ = 8192, C_AK = 10240, C_AV = 10368, C_AG = 10496,
              C_IQ = 12544, C_IK = 13568, C_IW = 13632, C_GA = 13824, C_GB = 15872;
constexpr float EPS = 1e-6f;
constexpr float LOG2E = 1.4426950408889634f;

constexpr size_t MiB = 1u << 20;
constexpr size_t WS_CTL = 0, CTL_BYTES = 1 * MiB;
constexpr size_t CTL_WQ = 0;
constexpr size_t CTL_XBAR = 512 * 1024;
constexpr size_t CTL_FLAG = 131072;
constexpr size_t CTL_SSQ = 65536;
constexpr size_t WS_TAB = 1 * MiB;
constexpr size_t WS_WIN = 4 * MiB;
constexpr size_t WIN_L = (size_t)NP * DM * 2;
constexpr size_t WS_WBR = WS_WIN + DEPTH * WIN_L;
constexpr size_t WBR_L = (size_t)4096 * DM * 2;
constexpr size_t WS_WOUT = WS_WBR + DEPTH * WBR_L;
constexpr size_t WOUT_L = (size_t)DM * DM * 2;
constexpr size_t WS_XN = WS_WOUT + DEPTH * WOUT_L;
constexpr size_t WS_P = WS_XN + (size_t)NTOK * DM * 2;
constexpr size_t WS_ACAT = WS_P + (size_t)NTOK * NP * 2;
constexpr size_t WS_G1 = WS_ACAT + (size_t)2 * NTOK * DM * 2;
constexpr size_t WS_MB = WS_G1 + (size_t)NTOK * DM * 4;
constexpr size_t WS_SSQ = WS_MB + (size_t)NTOK * DM * 2;
constexpr size_t WS_AKV = WS_SSQ + 1 * MiB;
constexpr size_t WS_IKC = WS_AKV + (size_t)NTOK * 256 * 2;
constexpr size_t WS_RQKV = WS_IKC + (size_t)NTOK * 128 * 2;
constexpr size_t RQKV_ONE = (size_t)NTOK * 2048 * 2;
constexpr size_t WS_RS = WS_RQKV + 3 * RQKV_ONE;
constexpr size_t WS_TS = WS_RS + (size_t)NTOK * 32 * 4;
constexpr size_t WS_END = WS_TS + (size_t)NBATCH * 8 * 8 * 256 * 256 * 2;

constexpr int LDS_BYTES = 147456;
constexpr int LDS_WQ_OFF = 140 * 1024;
constexpr int LDS_RTAB_OFF = 128 * 1024;

__device__ __forceinline__ float bf2f(unsigned short h) { return __uint_as_float((unsigned)h << 16); }
__device__ __forceinline__ float bflo(unsigned w) { return __uint_as_float(w << 16); }
__device__ __forceinline__ float bfhi(unsigned w) { return __uint_as_float(w & 0xffff0000u); }
__device__ __forceinline__ unsigned pk2(float lo, float hi) { unsigned r; asm("v_cvt_pk_bf16_f32 %0, %1, %2" : "=v"(r) : "v"(lo), "v"(hi)); return r; }
__device__ __forceinline__ float sigm(float v) { return __builtin_amdgcn_rcpf(1.f + __builtin_amdgcn_exp2f(-v * LOG2E)); }
__device__ __forceinline__ float wave_sum(float v) {
#pragma unroll
    for (int o = 1; o < 64; o <<= 1) v += __shfl_xor(v, o);
    return v;
}
__device__ __forceinline__ f32x4 mfma16(bf16x8 a, bf16x8 b, f32x4 c) { return __builtin_amdgcn_mfma_f32_16x16x32_bf16(a, b, c, 0, 0, 0); }
__device__ __forceinline__ s16x4 ldtr(LAS unsigned char* p) { return __builtin_amdgcn_ds_read_tr16_b64_v4i16((LAS s16x4*)p); }

struct ItemP { const float* src; bf16* dst; const float* gk; int ldw; int nvalid; };
__device__ __forceinline__ ItemP item_decode(const float* const* in, unsigned char* ws, int it) {
    constexpr int I_IN = 32 * 280, I_SQ = 32 * 32, I_L = I_IN + 3 * I_SQ;
    const int l = it / I_L; int r = it % I_L; ItemP p;
    if (r < I_IN) {
        const int kb = r / 280, db = r % 280;
        const int src_c0 = db <= 213 ? 64 * db : 64 * db - 176;
        p.nvalid = db < 213 ? 64 : (db == 213 ? 16 : (db < 216 ? 0 : 64));
        p.ldw = NSRC; p.src = in[2] + (size_t)l * DM * NSRC + (size_t)(64 * kb) * NSRC + src_c0;
        p.dst = (bf16*)(ws + WS_WIN + l * WIN_L) + (size_t)(64 * db) * DM + 64 * kb;
        p.gk = in[1] + l * DM + 64 * kb;
    } else {
        r -= I_IN; const int which = r / I_SQ; r %= I_SQ; const int kb = r / 32, db = r % 32;
        const float* W = (which == 0 ? in[7] : (which == 1 ? in[8] : in[9])) + (size_t)l * DM * DM;
        bf16* WT = which == 2 ? (bf16*)(ws + WS_WOUT + l * WOUT_L) : (bf16*)(ws + WS_WBR + l * WBR_L) + (size_t)which * DM * DM;
        p.gk = nullptr; p.nvalid = 64; p.ldw = DM; p.src = W + (size_t)(64 * kb) * DM + 64 * db; p.dst = WT + (size_t)(64 * db) * DM + 64 * kb;
    }
    return p;
}
__device__ __forceinline__ void item_load(const ItemP& p, f32x4 (&v)[16], int lane) {
    const int c4 = 4 * (lane & 15);
#pragma unroll
    for (int i = 0; i < 16; ++i) { v[i] = (f32x4){0.f, 0.f, 0.f, 0.f}; if (c4 < p.nvalid) v[i] = __builtin_nontemporal_load((const GAS f32x4*)(p.src + (size_t)(4 * i + (lane >> 4)) * p.ldw + c4)); }
    if (p.gk) {
#pragma unroll
        for (int i = 0; i < 16; ++i) v[i] = v[i] * p.gk[4 * i + (lane >> 4)]; }
}
__device__ __forceinline__ void item_store(const ItemP& p, const f32x4 (&v)[16], LAS float* scr, int lane) {
    const int c4 = 4 * (lane & 15);
#pragma unroll
    for (int i = 0; i < 16; ++i) { LAS float* d = scr + (4 * i + (lane >> 4)) * 65 + c4; d[0] = v[i].x; d[1] = v[i].y; d[2] = v[i].z; d[3] = v[i].w; }
    asm volatile("s_waitcnt lgkmcnt(0)" ::: "memory");
    const int c = lane & 7;
#pragma unroll
    for (int j = 0; j < 8; ++j) {
        const int n = 8 * j + (lane >> 3);
        const LAS float* s = scr + (8 * c) * 65 + n;
        u32x4 o; o.x = pk2(s[0], s[65]); o.y = pk2(s[2 * 65], s[3 * 65]); o.z = pk2(s[4 * 65], s[5 * 65]); o.w = pk2(s[6 * 65], s[7 * 65]);
        *(GAS u32x4*)(p.dst + (size_t)n * DM + 8 * c) = o;
    }
    asm volatile("s_waitcnt lgkmcnt(0)" ::: "memory");
}

__device__ __forceinline__ void cast_rows(const float* x, bf16* XN, float* RS, int gw, int NGW, int lane) {
    for (int m = gw; m < NTOK; m += NGW) {
        const GAS f32x4* xr = (const GAS f32x4*)(x + (size_t)m * DM) + lane;
        f32x4 v[8]; float s = 0.f;
#pragma unroll
        for (int j = 0; j < 8; ++j) { v[j] = xr[64 * j]; s += (v[j].x * v[j].x + v[j].y * v[j].y) + (v[j].z * v[j].z + v[j].w * v[j].w); }
        s = wave_sum(s);
        GAS u32x2* o = (GAS u32x2*)(XN + (size_t)m * DM) + lane;
#pragma unroll
        for (int j = 0; j < 8; ++j) { u32x2 w; w.x = pk2(v[j].x, v[j].y); w.y = pk2(v[j].z, v[j].w); o[64 * j] = w; }
        if (lane < 32) RS[(size_t)m * 32 + lane] = lane == 0 ? s : 0.f;
    }
}

__device__ __forceinline__ void p0_phase(const float* const* in, unsigned char* ws, LAS unsigned char* lds, int gw, int NGW, int wave, int lane, int gtid, int NGT) {
    float* rinv = (float*)(ws + WS_TAB);
    if (gtid < 128) rinv[gtid] = (float)(exp(-(double)gtid * (9.210340371976184 / 127.0)) * 0.15915494309189535);
    LAS float* scr = (LAS float*)(lds + wave * 16640);
    constexpr int N_ITEMS = 32 * 280 + 3 * 32 * 32;
    {
        f32x4 va[16], vb[16];
        int it = gw;
        ItemP pa = item_decode(in, ws, it < N_ITEMS ? it : 0), pb = pa;
        if (it < N_ITEMS) item_load(pa, va, lane);
        while (it < N_ITEMS) {
            const int itb = it + NGW;
            if (itb < N_ITEMS) { pb = item_decode(in, ws, itb); item_load(pb, vb, lane); }
            item_store(pa, va, scr, lane);
            if (itb >= N_ITEMS) break;
            const int ita = itb + NGW;
            if (ita < N_ITEMS) { pa = item_decode(in, ws, ita); item_load(pa, va, lane); }
            item_store(pb, vb, scr, lane);
            it = ita;
        }
    }
    cast_rows(in[0], (bf16*)(ws + WS_XN), (float*)(ws + WS_RS), gw, NGW, lane);
}

constexpr size_t CTL_CQ = 16384;
__device__ __forceinline__ void conv_drain(const float* const* in, unsigned char* ws, LAS unsigned char* lds, int layer, int tid) {
    constexpr int I_L = 32 * 280 + 3 * 32 * 32;
    unsigned* ctr = (unsigned*)(ws + CTL_CQ + 256 * layer);
    LAS int* wq = (LAS int*)(lds + LDS_WQ_OFF);
    const int lane = tid & 63, w = __builtin_amdgcn_readfirstlane(tid >> 6);
    LAS float* scr = (LAS float*)(lds + w * 16640);
    for (;;) {
        __syncthreads();
        if (tid == 0) wq[0] = (int)atomicAdd(ctr, 16u);
        __syncthreads();
        const int base = __builtin_amdgcn_readfirstlane(wq[0]);
        if (base >= I_L) break;
        f32x4 va[16], vb[16];
        const ItemP pa = item_decode(in, ws, layer * I_L + base + w), pb = item_decode(in, ws, layer * I_L + base + 8 + w);
        item_load(pa, va, lane); item_load(pb, vb, lane);
        item_store(pa, va, scr, lane); item_store(pb, vb, scr, lane);
    }
}

__device__ __forceinline__ float bperm_f(int src4, float v) { return __int_as_float(__builtin_amdgcn_ds_bpermute(src4, __float_as_int(v))); }
__device__ __forceinline__ unsigned bperm_u(int src4, unsigned v) { return (unsigned)__builtin_amdgcn_ds_bpermute(src4, (int)v); }
__device__ __forceinline__ f32x4 bperm_f4(int src4, f32x4 v) { return (f32x4){bperm_f(src4, v.x), bperm_f(src4, v.y), bperm_f(src4, v.z), bperm_f(src4, v.w)}; }
__device__ __forceinline__ u32x4 bperm_u4(int src4, u32x4 v) { u32x4 r; r.x = bperm_u(src4, v.x); r.y = bperm_u(src4, v.y); r.z = bperm_u(src4, v.z); r.w = bperm_u(src4, v.w); return r; }
struct EpiP {
    static constexpr bool PERM = true, AFTER_DRAIN = false;
    bf16* P; const float* cosT; const float* sinT; const float* akg; const float* ikg; float* ssq_ak; float* ssq_ik; bf16* AKV; bf16* IKC; bf16* RQKV; const LAS float* rtab; int rbase;
    __device__ __forceinline__ void operator()(const pg8::f32x4 (&acc)[2][2][4][2], const pg8::Unit& u, int wr, int wc, int fr, int fq) const {
        const int pn = u.pn;
        const int row0 = u.pm * 256 + wr * 64 + fr;
        const int cl = wc * 32 + 8 * fq;
        const int rowm0 = row0, clm = cl;
        int type;
        if (pn < 8) type = 1; else if (pn < 16) type = 2; else if (pn < 24) type = 0; else if (pn < 32) type = 3; else if (pn < 40) type = 0;
        else if (pn == 40) type = 5; else if (pn < 49) type = 3; else if (pn < 53) type = 0; else if (pn == 53) type = 6; else type = 4;
        f32x4 rv0 = (f32x4){0.f, 0.f, 0.f, 0.f}, rv1 = rv0;
        if (type == 1 || type == 2) { rv0 = *(const GAS f32x4*)(cosT + cl); rv1 = *(const GAS f32x4*)(cosT + cl + 4); }
#pragma unroll
        for (int ai = 0; ai < 2; ++ai)
#pragma unroll
            for (int m = 0; m < 4; ++m) {
                const int row = row0 + ai * 128 + m * 16;
                float a[8], b[8];
#pragma unroll
                for (int e = 0; e < 4; ++e) { a[e] = acc[ai][0][m][0][e]; a[4 + e] = acc[ai][0][m][1][e]; b[e] = acc[ai][1][m][0][e]; b[4 + e] = acc[ai][1][m][1][e]; }
                { const float rr = rtab[row - rbase];
#pragma unroll
                  for (int e = 0; e < 8; ++e) { a[e] *= rr; b[e] *= rr; } }
                if (type == 1 || type == 2) {
                    const float pos = (float)(row & 2047); const float sc = type == 2 ? 0.0625f : 1.f;
#pragma unroll
                    for (int e = 0; e < 8; ++e) { const float fx = __builtin_amdgcn_fractf(pos * (e < 4 ? rv0[e & 3] : rv1[e & 3]));
                        const float c = __builtin_amdgcn_cosf(fx) * sc, s = __builtin_amdgcn_sinf(fx) * sc; const float x1 = a[e], x2 = b[e]; a[e] = x1 * c - x2 * s; b[e] = x2 * c + x1 * s; }
                } else if (type == 3) {
#pragma unroll
                    for (int e = 0; e < 8; ++e) { a[e] = a[e] * sigm(a[e]); b[e] = b[e] * sigm(b[e]); }
                } else if (type == 4) {
#pragma unroll
                    for (int e = 0; e < 8; ++e) { a[e] = sigm(a[e]); b[e] = sigm(b[e]); }
                } else if (type == 5) {
                    float ss = 0.f;
#pragma unroll
                    for (int e = 0; e < 8; ++e) { ss += a[e] * a[e]; a[e] *= akg[cl + e]; }
                    ss += __shfl_xor(ss, 16); ss += __shfl_xor(ss, 32);
                    if (fq == 0) ((GAS float*)ssq_ak)[row * 4 + wc] = ss;
                } else if (type == 6) {
                    if (wc < 2) {
                        float ss = 0.f;
#pragma unroll
                        for (int e = 0; e < 8; ++e) { ss += a[e] * a[e]; a[e] *= ikg[cl + e]; }
                        ss += __shfl_xor(ss, 16); ss += __shfl_xor(ss, 32);
                        if (fq == 0) ((GAS float*)ssq_ik)[row * 2 + wc] = ss;
                    }
                }
                u32x4 w0, w1;
                w0.x = pk2(a[0], a[1]); w0.y = pk2(a[2], a[3]); w0.z = pk2(a[4], a[5]); w0.w = pk2(a[6], a[7]);
                w1.x = pk2(b[0], b[1]); w1.y = pk2(b[2], b[3]); w1.z = pk2(b[4], b[5]); w1.w = pk2(b[6], b[7]);
                const int rowm = rowm0 + ai * 128 + m * 16;
                bf16* rowp = P + (size_t)rowm * NP + pn * 256 + clm;
                if (type == 5) rowp = AKV + (size_t)rowm * 256 + clm;
                if (pn < 24) rowp = RQKV + (size_t)(pn >> 3) * (RQKV_ONE / 2) + ((size_t)(((rowm >> 11) * 8 + (pn & 7)) * 2048 + (rowm & 2047))) * 256 + clm;
                if (type == 6) { *(GAS u32x4*)(IKC + (size_t)rowm * 128 + clm) = w0; } else { *(GAS u32x4*)rowp = w0; *(GAS u32x4*)(rowp + 128) = w1; }
            }
    }
};

struct EpiBr {
    static constexpr bool PERM = true, AFTER_DRAIN = false;
    const bf16* P; float* G1; bf16* MB;
    __device__ __forceinline__ void operator()(const pg8::f32x4 (&acc)[2][2][4][2], const pg8::Unit& u, int wr, int wc, int fr, int fq) const {
        const bool att = u.pm >= 32;
        const int row0 = (u.pm & 31) * 256 + wr * 64 + fr, col0 = (u.pn & 7) * 256 + wc * 32 + 8 * fq;
        const int gcol = att ? C_GB : C_GA;
        if (!att) {
#pragma unroll
            for (int ai = 0; ai < 2; ++ai) {
                u32x4 gt[4][2];
#pragma unroll
                for (int m = 0; m < 4; ++m)
#pragma unroll
                    for (int bj = 0; bj < 2; ++bj) gt[m][bj] = *(const GAS u32x4*)(P + (size_t)(row0 + ai * 128 + m * 16) * NP + gcol + col0 + bj * 128);
                __builtin_amdgcn_sched_barrier(0);
#pragma unroll
                for (int m = 0; m < 4; ++m)
#pragma unroll
                    for (int bj = 0; bj < 2; ++bj) {
                        const u32x4 g = gt[m][bj]; const f32x4 a0 = acc[ai][bj][m][0], a1 = acc[ai][bj][m][1];
                        float* gp = G1 + (size_t)(row0 + ai * 128 + m * 16) * DM + col0 + bj * 128;
                        *(GAS f32x4*)gp = (f32x4){a0.x * bflo(g.x), a0.y * bfhi(g.x), a0.z * bflo(g.y), a0.w * bfhi(g.y)};
                        *(GAS f32x4*)(gp + 4) = (f32x4){a1.x * bflo(g.z), a1.y * bfhi(g.z), a1.z * bflo(g.w), a1.w * bfhi(g.w)};
                    }
                __builtin_amdgcn_sched_barrier(0);
            }
        } else {
#pragma unroll
            for (int ai = 0; ai < 2; ++ai)
#pragma unroll
                for (int mp = 0; mp < 2; ++mp) {
                    u32x4 gt[2][2]; f32x4 g1[2][2][2];
#pragma unroll
                    for (int mm = 0; mm < 2; ++mm)
#pragma unroll
                        for (int bj = 0; bj < 2; ++bj) { const int row = row0 + ai * 128 + (2 * mp + mm) * 16, c = col0 + bj * 128;
                            gt[mm][bj] = *(const GAS u32x4*)(P + (size_t)row * NP + gcol + c);
                            g1[mm][bj][0] = *(const GAS f32x4*)(G1 + (size_t)row * DM + c); g1[mm][bj][1] = *(const GAS f32x4*)(G1 + (size_t)row * DM + c + 4); }
                    __builtin_amdgcn_sched_barrier(0);
#pragma unroll
                    for (int mm = 0; mm < 2; ++mm)
#pragma unroll
                        for (int bj = 0; bj < 2; ++bj) { const int m = 2 * mp + mm; const int row = row0 + ai * 128 + m * 16, c = col0 + bj * 128;
                            const u32x4 g = gt[mm][bj]; const f32x4 a0 = acc[ai][bj][m][0], a1 = acc[ai][bj][m][1], h0 = g1[mm][bj][0], h1 = g1[mm][bj][1];
                            u32x4 w; w.x = pk2(a0.x * bflo(g.x) + h0.x, a0.y * bfhi(g.x) + h0.y); w.y = pk2(a0.z * bflo(g.y) + h0.z, a0.w * bfhi(g.y) + h0.w);
                            w.z = pk2(a1.x * bflo(g.z) + h1.x, a1.y * bfhi(g.z) + h1.y); w.w = pk2(a1.z * bflo(g.w) + h1.z, a1.w * bfhi(g.w) + h1.w);
                            *(GAS u32x4*)(MB + (size_t)row * DM + c) = w; }
                    __builtin_amdgcn_sched_barrier(0);
                }
        }
    }
};
struct BrOrder {
    int G, c;
    __device__ bool next(int i, pg8::Unit& u) const {
        const int p = (i >> 1) * G + c; if (p >= 256) return false;
        const int x = p & 7, q = p >> 3; int pm = 4 * x + (q >> 3), pn = q & 7;
        if (i & 1) { pm += 32; pn += 8; }
        u.pm = pm; u.pn = pn; return true;
    }
    __device__ __forceinline__ void a_ready(const pg8::Unit&) const {}
    __device__ __forceinline__ void done(const pg8::Unit&) const {}
};
struct EpiOut {
    static constexpr bool PERM = true, AFTER_DRAIN = false;
    const float* xold; float* out; bf16* XN; float* RS;
    __device__ __forceinline__ void operator()(const pg8::f32x4 (&acc)[2][2][4][2], const pg8::Unit& u, int wr, int wc, int fr, int fq) const {
        const int row0 = u.pm * 256 + wr * 64 + fr, col0 = u.pn * 256 + wc * 32 + 8 * fq;
#pragma unroll
        for (int ai = 0; ai < 2; ++ai) {
            f32x4 xo[4][2][2];
#pragma unroll
            for (int m = 0; m < 4; ++m)
#pragma unroll
                for (int bj = 0; bj < 2; ++bj) { const size_t off = (size_t)(row0 + ai * 128 + m * 16) * DM + col0 + bj * 128; xo[m][bj][0] = *(const GAS f32x4*)(xold + off); xo[m][bj][1] = *(const GAS f32x4*)(xold + off + 4); }
            __builtin_amdgcn_sched_barrier(0);
#pragma unroll
            for (int m = 0; m < 4; ++m) {
                const int row = row0 + ai * 128 + m * 16; float ss = 0.f;
#pragma unroll
                for (int bj = 0; bj < 2; ++bj) {
                    const size_t off = (size_t)row * DM + col0 + bj * 128;
                    const f32x4 x0 = xo[m][bj][0] + acc[ai][bj][m][0], x1 = xo[m][bj][1] + acc[ai][bj][m][1];
                    *(GAS f32x4*)(out + off) = x0; *(GAS f32x4*)(out + off + 4) = x1;
                    if (XN) { u32x4 w; w.x = pk2(x0.x, x0.y); w.y = pk2(x0.z, x0.w); w.z = pk2(x1.x, x1.y); w.w = pk2(x1.z, x1.w); *(GAS u32x4*)(XN + off) = w;
                        ss += (x0.x * x0.x + x0.y * x0.y) + (x0.z * x0.z + x0.w * x0.w) + (x1.x * x1.x + x1.y * x1.y) + (x1.z * x1.z + x1.w * x1.w); }
                }
                if (XN) { ss += __shfl_xor(ss, 16); ss += __shfl_xor(ss, 32); if (fq == 0) ((GAS float*)RS)[(size_t)row * 32 + u.pn * 4 + wc] = ss; }
            }
            __builtin_amdgcn_sched_barrier(0);
        }
    }
};
#define RLX_AGENT __ATOMIC_RELAXED, __HIP_MEMORY_SCOPE_AGENT
#define XB_TMO      128
#define XB_XCNT(j)  (256  + 64 * (j))
#define XB_XSUB(j)  (1280 + 64 * (j))
#define XB_XGEN(j)  (2304 + 64 * (j))
#define XB_TOP      3328
#define XB_TOPGEN   3392
#define XCD_BAR_WORDS 3456
#define XB_SPIN_CAP (1u << 18)

__device__ __forceinline__ unsigned xb_ld(unsigned* p)              { return __hip_atomic_load(p, __ATOMIC_RELAXED, __HIP_MEMORY_SCOPE_AGENT); }
__device__ __forceinline__ unsigned xb_add(unsigned* p, unsigned v) { return __hip_atomic_fetch_add(p, v, __ATOMIC_RELAXED, __HIP_MEMORY_SCOPE_AGENT); }
__device__ __forceinline__ unsigned xb_xcc_id() { return (unsigned)__builtin_amdgcn_s_getreg((3 << 11) | 20) & 0xFu; }
#define XB_SPIN(cond, bar) do { unsigned _sp = 0; while (cond) { __builtin_amdgcn_s_sleep(1); \
    if ((++_sp & 255u) == 0u) { if (xb_ld(&(bar)[XB_TMO])) break; if (_sp > XB_SPIN_CAP) { atomicAdd(&(bar)[XB_TMO], 1u); break; } } } } while (0)

struct XcdBarrier {
    unsigned* bar; unsigned x;
    volatile LAS unsigned* st;
};

__device__ __forceinline__ XcdBarrier xcd_barrier_post(unsigned* bar, volatile LAS unsigned* st) {
    XcdBarrier b; b.bar = bar; b.x = xb_xcc_id(); b.st = st;
    if (threadIdx.x == 0) (void)xb_add(&bar[XB_XCNT(b.x)], 1u);
    return b;
}
__device__ __forceinline__ void xcd_barrier_complete(unsigned* bar, unsigned x, unsigned& nloc, unsigned& nx) {
    const unsigned G = gridDim.x * gridDim.y * gridDim.z;
    unsigned sum, cnt, mine, sp = 0u;
    for (;;) {
        sum = 0u; cnt = 0u; mine = 0u;
#pragma unroll
        for (unsigned j = 0; j < 16; ++j) { const unsigned c = xb_ld(&bar[XB_XCNT(j)]); sum += c; cnt += (c > 0u) ? 1u : 0u; mine = (j == x) ? c : mine; }
        if (sum == G) break;
        __builtin_amdgcn_s_sleep(1);
        if ((++sp & 255u) == 0u) { if (xb_ld(&bar[XB_TMO])) break; if (sp > XB_SPIN_CAP) { atomicAdd(&bar[XB_TMO], 1u); break; } }
    }
    nloc = mine > 0u ? mine : 1u; nx = cnt > 0u ? cnt : 1u;
}

__device__ __forceinline__ void xcd_barrier(const XcdBarrier& b) {
    asm volatile("s_waitcnt vmcnt(0)" ::: "memory");
    __syncthreads();
    if (threadIdx.x == 0) {
        unsigned* bar = b.bar;
        __builtin_amdgcn_s_waitcnt(0);
        unsigned nloc = b.st[0], nx = b.st[1];
        if (nloc == 0u) { xcd_barrier_complete(bar, b.x, nloc, nx); b.st[0] = nloc; b.st[1] = nx; }
        const unsigned old = xb_add(&bar[XB_XSUB(b.x)], 1u);
        const unsigned gen = old / nloc;
        if (old + 1u == (gen + 1u) * nloc) {
            __builtin_amdgcn_fence(__ATOMIC_RELEASE, "agent");
            asm volatile("s_waitcnt vmcnt(0)" ::: "memory");
            const unsigned og = xb_add(&bar[XB_TOP], 1u);
            const unsigned tg = og / nx;
            if (og + 1u == (tg + 1u) * nx) xb_add(&bar[XB_TOPGEN], 1u);
            else XB_SPIN(xb_ld(&bar[XB_TOPGEN]) == tg, bar);
            __builtin_amdgcn_fence(__ATOMIC_ACQUIRE, "agent");
            xb_add(&bar[XB_XGEN(b.x)], 1u);
            asm volatile("s_waitcnt vmcnt(0)" ::: "memory");
        } else {
            XB_SPIN(xb_ld(&bar[XB_XGEN(b.x)]) == gen, bar);
            __builtin_amdgcn_fence(__ATOMIC_ACQUIRE, "agent");
            asm volatile("s_waitcnt vmcnt(0)" ::: "memory");
        }
    }
    __syncthreads();
}
__device__ __forceinline__ void state_unit(LAS unsigned char* lds, const bf16* RQKV, bf16* TS, unsigned* flag, int b, int h, int e, int tid) {
    asm volatile("" : "+s"(RQKV), "+s"(TS), "+s"(flag), "+s"(e), "+v"(tid));
    const int lane = tid & 63, w = __builtin_amdgcn_readfirstlane(tid >> 6), fr = lane & 15, fq = lane >> 4;
    const bf16* RK = RQKV + RQKV_ONE / 2 + (size_t)((b * 8 + h) * 2048) * 256; const bf16* RV = RK + RQKV_ONE / 2;
    bf16* TSb = TS + (size_t)((b * 8 + h) * 8) * 65536;
    constexpr int KB = 64 * 528, VPITCH = 144, VB = 64 * VPITCH, SBUF = KB + VB;
    const float l2g = __log2f(1.f - exp2f(-5.f - (float)h));
    const float c64 = __builtin_amdgcn_exp2f(64.f * l2g);
    f32x4 T[2][4];
#pragma unroll
    for (int i = 0; i < 2; ++i)
#pragma unroll
        for (int j = 0; j < 4; ++j) T[i][j] = (f32x4){0.f, 0.f, 0.f, 0.f};
    const int srow = tid >> 5, sch = tid & 31;
    const size_t soff = (size_t)srow * 256 + sch * 8;
    const int vtok = tid >> 3, vpc = tid & 7;
    const size_t voff = (size_t)vtok * 256 + 64 * e + vpc * 8;
    const float vsc = __builtin_amdgcn_exp2f((float)(63 - vtok) * l2g);
    u32x4 kreg[4][4], vreg[4];
#pragma unroll
    for (int ts = 0; ts < 4; ++ts) {
#pragma unroll
        for (int i = 0; i < 4; ++i) kreg[ts][i] = __builtin_nontemporal_load((const GAS u32x4*)(RK + soff + (size_t)(64 * ts + 16 * i) * 256));
        vreg[ts] = *(const GAS u32x4*)(RV + voff + (size_t)(64 * ts) * 256);
    }
    __syncthreads();
#pragma unroll 1
    for (int tb = 0; tb < 7; ++tb) {
#pragma unroll
        for (int ts = 0; ts < 4; ++ts) {
            const int tt = 4 * tb + ts;
            LAS unsigned char* Ks = lds + (ts & 1) * SBUF; LAS unsigned char* Vs = Ks + KB;
#pragma unroll
            for (int i = 0; i < 4; ++i) *(LAS u32x4*)(Ks + (srow + 16 * i) * 528 + sch * 16) = kreg[ts][i];
            { const u32x4 v = vreg[ts]; u32x4 o; o.x = pk2(bflo(v.x) * vsc, bfhi(v.x) * vsc); o.y = pk2(bflo(v.y) * vsc, bfhi(v.y) * vsc); o.z = pk2(bflo(v.z) * vsc, bfhi(v.z) * vsc); o.w = pk2(bflo(v.w) * vsc, bfhi(v.w) * vsc);
              *(LAS u32x4*)(Vs + vtok * VPITCH + vpc * 16) = o; }
            __syncthreads();
            if (tb < 6) {
#pragma unroll
                for (int i = 0; i < 4; ++i) kreg[ts][i] = __builtin_nontemporal_load((const GAS u32x4*)(RK + soff + (size_t)(64 * (tt + 4) + 16 * i) * 256));
                vreg[ts] = *(const GAS u32x4*)(RV + voff + (size_t)(64 * (tt + 4)) * 256);
            }
#pragma unroll
            for (int i = 0; i < 2; ++i)
#pragma unroll
                for (int j = 0; j < 4; ++j) T[i][j] = T[i][j] * c64;
#pragma unroll
            for (int G = 0; G < 2; ++G) {
                const int trow = 32 * G + 8 * fq + (fr >> 2);
                bf16x8 Af[2], Bf[4];
#pragma unroll
                for (int d = 0; d < 2; ++d) { LAS unsigned char* a1 = Ks + trow * 528 + (16 * (2 * w + d) + 4 * (fr & 3)) * 2; const s16x4 t1 = ldtr(a1), t2 = ldtr(a1 + 4 * 528); Af[d] = __builtin_shufflevector(t1, t2, 0, 1, 2, 3, 4, 5, 6, 7); }
#pragma unroll
                for (int d = 0; d < 4; ++d) { LAS unsigned char* a1 = Vs + trow * VPITCH + (16 * d + 4 * (fr & 3)) * 2; const s16x4 t1 = ldtr(a1), t2 = ldtr(a1 + 4 * VPITCH); Bf[d] = __builtin_shufflevector(t1, t2, 0, 1, 2, 3, 4, 5, 6, 7); }
#pragma unroll
                for (int i = 0; i < 2; ++i)
#pragma unroll
                    for (int j = 0; j < 4; ++j) T[i][j] = mfma16(Af[i], Bf[j], T[i][j]);
            }
            if (ts == 3) {
                GAS bf16* o = (GAS bf16*)(TSb + (size_t)(tb + 1) * 65536);
#pragma unroll
                for (int i = 0; i < 2; ++i)
#pragma unroll
                    for (int j = 0; j < 4; ++j) { u32x2 pk; pk.x = pk2(T[i][j][0], T[i][j][1]); pk.y = pk2(T[i][j][2], T[i][j][3]);
                        *(GAS u32x2*)(o + (size_t)(64 * e + 16 * j + fr) * 256 + 16 * (2 * w + i) + 4 * fq) = pk; }
            }
        }
    }
    asm volatile("s_waitcnt vmcnt(0)" ::: "memory");
    __syncthreads();
    if (tid == 0) {
        __builtin_amdgcn_fence(__ATOMIC_RELEASE, "agent");
        asm volatile("s_waitcnt vmcnt(0)" ::: "memory");
        __hip_atomic_fetch_add((GAS unsigned*)flag, 1u, __ATOMIC_RELAXED, __HIP_MEMORY_SCOPE_AGENT);
    }
}

__device__ __forceinline__ void ret_unit(LAS unsigned char* lds, const bf16* P, const bf16* RQKV, const bf16* TS, unsigned* flag, bf16* ACAT, const float* rog, int b, int h, int qb, int tid) {
    asm volatile("" : "+s"(P), "+s"(RQKV), "+s"(TS), "+s"(flag), "+s"(ACAT), "+s"(rog), "+s"(qb), "+v"(tid));
    const bf16* RQ = RQKV + (size_t)((b * 8 + h) * 2048) * 256; const bf16* RK = RQ + RQKV_ONE / 2; const bf16* RV = RK + RQKV_ONE / 2;
    const int lane = tid & 63, w = __builtin_amdgcn_readfirstlane(tid >> 6), fr = lane & 15, fq = lane >> 4;
    constexpr int BUFB = 64 * 528 + 64 * 544;
    const int qi = 128 * qb + 16 * w + fr;
    const size_t tq = (size_t)(b * SEQ + qi);
    f32x4 O[16];
#pragma unroll
    for (int nb = 0; nb < 16; ++nb) O[nb] = (f32x4){0.f, 0.f, 0.f, 0.f};
    const float l2g = __log2f(1.f - exp2f(-5.f - (float)h));
    const int nkt = 2 * qb + 2;
    const int qc = 2 * qb + (w >> 2);
    const int srow = tid >> 5, sch = tid & 31;
    const size_t soff = (size_t)srow * 256 + sch * 8;
    u32x4 kreg[4], vreg[4];
    const int sc = qb >> 1, m0 = 4 * sc;
    bf16x8 Qf[8];
#pragma unroll
    for (int kk = 0; kk < 8; ++kk) Qf[kk] = *(const GAS bf16x8*)(RQ + (size_t)qi * 256 + 32 * kk + 8 * fq);
    f32x4 ca[4];
    float l2gp = l2g; asm volatile("" : "+v"(l2gp));
    { const float ai = __builtin_amdgcn_exp2f((float)(16 * (w & 3) + fr) * l2gp);
#pragma unroll
      for (int g = 0; g < 4; ++g)
#pragma unroll
          for (int r = 0; r < 4; ++r) ca[g][r] = ai * __builtin_amdgcn_exp2f(-(float)(16 * g + 4 * fq + r) * l2gp); }
#pragma unroll
    for (int i = 0; i < 4; ++i) { const size_t o = soff + (size_t)(64 * m0 + 16 * i) * 256; kreg[i] = __builtin_nontemporal_load((const GAS u32x4*)(RK + o)); vreg[i] = __builtin_nontemporal_load((const GAS u32x4*)(RV + o)); }
#pragma unroll
    for (int i = 0; i < 4; ++i) { *(LAS u32x4*)(lds + (srow + 16 * i) * 528 + sch * 16) = kreg[i]; *(LAS u32x4*)(lds + 64 * 528 + (srow + 16 * i) * 544 + sch * 16) = vreg[i]; }
    __syncthreads();
    for (int m = m0; m < nkt; ++m) {
        LAS unsigned char* Ks = lds + (m & 1) * BUFB; LAS unsigned char* Vs = Ks + 64 * 528;
        if (m + 1 < nkt) {
#pragma unroll
            for (int i = 0; i < 4; ++i) { const size_t o = soff + (size_t)(64 * (m + 1) + 16 * i) * 256; kreg[i] = __builtin_nontemporal_load((const GAS u32x4*)(RK + o)); vreg[i] = __builtin_nontemporal_load((const GAS u32x4*)(RV + o)); }
        }
        if (m <= qc) {
            f32x4 S[4];
#pragma unroll
            for (int g = 0; g < 4; ++g) S[g] = (f32x4){0.f, 0.f, 0.f, 0.f};
            {
                const LAS unsigned char* kb = Ks + fr * 528 + fq * 16;
                bf16x8 Kc[4], Kn[4];
#pragma unroll
                for (int g = 0; g < 4; ++g) Kc[g] = *(const LAS bf16x8*)(kb + g * (16 * 528));
#pragma unroll
                for (int kk = 0; kk < 8; ++kk) {
                    if (kk + 1 < 8) {
#pragma unroll
                        for (int g = 0; g < 4; ++g) Kn[g] = *(const LAS bf16x8*)(kb + g * (16 * 528) + (kk + 1) * 64); }
                    __builtin_amdgcn_sched_barrier(0);
#pragma unroll
                    for (int g = 0; g < 4; ++g) S[g] = mfma16(Kc[g], Qf[kk], S[g]);
                    __builtin_amdgcn_sched_barrier(0);
                    if (kk + 1 < 8) {
#pragma unroll
                        for (int g = 0; g < 4; ++g) Kc[g] = Kn[g]; }
                }
            }
            if (m < qc) {
                const float tm = __builtin_amdgcn_exp2f((float)(64 * (qc - m)) * l2g);
#pragma unroll
                for (int g = 0; g < 4; ++g) S[g] = S[g] * (ca[g] * tm);
            } else {
#pragma unroll
                for (int g = 0; g < 4; ++g)
#pragma unroll
                    for (int r = 0; r < 4; ++r) { const int j = 64 * m + 16 * g + 4 * fq + r; const int d = qi > j ? qi - j : j - qi; S[g][r] *= __builtin_amdgcn_exp2f((float)d * l2g); }
            }
            bf16x8 Pf[2];
#pragma unroll
            for (int G = 0; G < 2; ++G) { u32x4 t; t.x = pk2(S[2 * G][0], S[2 * G][1]); t.y = pk2(S[2 * G][2], S[2 * G][3]); t.z = pk2(S[2 * G + 1][0], S[2 * G + 1][1]); t.w = pk2(S[2 * G + 1][2], S[2 * G + 1][3]); Pf[G] = __builtin_bit_cast(bf16x8, t); }
            {
                const LAS unsigned char* vbse = Vs + (4 * fq + (fr >> 2)) * 544 + (4 * (fr & 3)) * 2;
                s16x4 tc[2][2][2], tn[2][2][2];
#pragma unroll
                for (int u = 0; u < 2; ++u)
#pragma unroll
                    for (int G = 0; G < 2; ++G) { tc[u][G][0] = ldtr((LAS unsigned char*)vbse + 32 * G * 544 + 32 * u); tc[u][G][1] = ldtr((LAS unsigned char*)vbse + (32 * G + 16) * 544 + 32 * u); }
#pragma unroll
                for (int np = 0; np < 8; ++np) {
                    if (np + 1 < 8) {
#pragma unroll
                        for (int u = 0; u < 2; ++u)
#pragma unroll
                            for (int G = 0; G < 2; ++G) { tn[u][G][0] = ldtr((LAS unsigned char*)vbse + 32 * G * 544 + 32 * (2 * (np + 1) + u)); tn[u][G][1] = ldtr((LAS unsigned char*)vbse + (32 * G + 16) * 544 + 32 * (2 * (np + 1) + u)); } }
                    __builtin_amdgcn_sched_barrier(0);
#pragma unroll
                    for (int G = 0; G < 2; ++G)
#pragma unroll
                        for (int u = 0; u < 2; ++u)
                            O[2 * np + u] = mfma16(__builtin_shufflevector(tc[u][G][0], tc[u][G][1], 0, 1, 2, 3, 4, 5, 6, 7), Pf[G], O[2 * np + u]);
                    __builtin_amdgcn_sched_barrier(0);
                    if (np + 1 < 8) {
#pragma unroll
                        for (int u = 0; u < 2; ++u)
#pragma unroll
                            for (int G = 0; G < 2; ++G) { tc[u][G][0] = tn[u][G][0]; tc[u][G][1] = tn[u][G][1]; } }
                }
            }
        }
        if (m + 1 < nkt) {
            LAS unsigned char* Kn = lds + ((m + 1) & 1) * BUFB;
#pragma unroll
            for (int i = 0; i < 4; ++i) { *(LAS u32x4*)(Kn + (srow + 16 * i) * 528 + sch * 16) = kreg[i]; *(LAS u32x4*)(Kn + 64 * 528 + (srow + 16 * i) * 544 + sch * 16) = vreg[i]; }
        }
        __syncthreads();
    }
    if (sc > 0) {
        if (tid == 0) {
            unsigned spins = 0;
            while (__hip_atomic_load((GAS unsigned*)flag, __ATOMIC_RELAXED, __HIP_MEMORY_SCOPE_AGENT) < 4u) { __builtin_amdgcn_s_sleep(2); if (++spins > (1u << 22)) break; }
            __builtin_amdgcn_fence(__ATOMIC_ACQUIRE, "agent");
            asm volatile("s_waitcnt vmcnt(0)" ::: "memory");
        }
        __syncthreads();
        const float ai = __builtin_amdgcn_exp2f((float)(qi - 256 * sc + 1) * l2g);
        bf16x8 Qs[8];
#pragma unroll
        for (int kk = 0; kk < 8; ++kk) { const u32x4 qr = *(const GAS u32x4*)(RQ + (size_t)qi * 256 + 32 * kk + 8 * fq); u32x4 qs;
            qs.x = pk2(bflo(qr.x) * ai, bfhi(qr.x) * ai); qs.y = pk2(bflo(qr.y) * ai, bfhi(qr.y) * ai); qs.z = pk2(bflo(qr.z) * ai, bfhi(qr.z) * ai); qs.w = pk2(bflo(qr.w) * ai, bfhi(qr.w) * ai); Qs[kk] = __builtin_bit_cast(bf16x8, qs); }
        const bf16* TSb = TS + (size_t)(((b * 8 + h) * 8 + sc) * 256) * 256;
#pragma unroll
        for (int i = 0; i < 4; ++i) vreg[i] = *(const GAS u32x4*)(TSb + soff + (size_t)(16 * i) * 256);
#pragma unroll
        for (int td = 0; td < 4; ++td) {
            __syncthreads();
#pragma unroll
            for (int i = 0; i < 4; ++i) *(LAS u32x4*)(lds + (srow + 16 * i) * 528 + sch * 16) = vreg[i];
            __syncthreads();
            if (td + 1 < 4) {
#pragma unroll
                for (int i = 0; i < 4; ++i) vreg[i] = *(const GAS u32x4*)(TSb + soff + (size_t)(64 * (td + 1) + 16 * i) * 256); }
            const LAS unsigned char* tb0 = lds + fr * 528 + fq * 16;
#pragma unroll
            for (int np = 0; np < 2; ++np) {
                bf16x8 Af[2][8];
#pragma unroll
                for (int u = 0; u < 2; ++u)
#pragma unroll
                    for (int kk = 0; kk < 8; ++kk) Af[u][kk] = *(const LAS bf16x8*)(tb0 + (16 * (2 * np + u)) * 528 + kk * 64);
                __builtin_amdgcn_sched_barrier(0);
#pragma unroll
                for (int kk = 0; kk < 8; ++kk)
#pragma unroll
                    for (int u = 0; u < 2; ++u) O[4 * td + 2 * np + u] = mfma16(Af[u][kk], Qs[kk], O[4 * td + 2 * np + u]);
                __builtin_amdgcn_sched_barrier(0);
            }
        }
        __syncthreads();
    }
    float ss = 0.f;
#pragma unroll
    for (int nb = 0; nb < 16; ++nb) ss += (O[nb][0] * O[nb][0] + O[nb][1] * O[nb][1]) + (O[nb][2] * O[nb][2] + O[nb][3] * O[nb][3]);
    ss += __shfl_xor(ss, 16); ss += __shfl_xor(ss, 32);
    const float rn = rsqrtf(ss * (1.f / 256.f) + EPS);
    LAS float* Ot = (LAS float*)(lds + w * 16640);
#pragma unroll
    for (int nb = 0; nb < 16; ++nb) *(LAS f32x4*)(Ot + fr * 260 + 16 * nb + 4 * fq) = O[nb] * rn;
    __builtin_amdgcn_fence(__ATOMIC_RELEASE, "wavefront"); __builtin_amdgcn_wave_barrier();
    {
        const f32x4 gv = *(const GAS f32x4*)(rog + h * 256 + 4 * lane);
        const size_t t0r = (size_t)(b * SEQ + 128 * qb + 16 * w);
        u32x2 sg[16];
#pragma unroll
        for (int i = 0; i < 16; ++i) sg[i] = *(const GAS u32x2*)(P + (t0r + i) * NP + C_RG + h * 256 + 4 * lane);
#pragma unroll
        for (int i = 0; i < 16; ++i) {
            const f32x4 o4 = *(const LAS f32x4*)(Ot + i * 260 + 4 * lane);
            u32x2 o; o.x = pk2(o4.x * gv.x * bflo(sg[i].x), o4.y * gv.y * bfhi(sg[i].x)); o.y = pk2(o4.z * gv.z * bflo(sg[i].y), o4.w * gv.w * bfhi(sg[i].y));
            *(GAS u32x2*)(ACAT + (t0r + i) * DM + h * 256 + 4 * lane) = o;
        }
    }
    __syncthreads();
}

typedef unsigned u32x2v __attribute__((ext_vector_type(2)));
__device__ __forceinline__ float half_sum32(float a, float b, float& hi_out) {
    const u32x2v r = __builtin_amdgcn_permlane32_swap(__float_as_uint(a), __float_as_uint(b), false, false);
    (void)hi_out; return __uint_as_float(r.x) + __uint_as_float(r.y);
}
__device__ __forceinline__ void topk_list(const unsigned (&uk)[32], LAS int* list, LAS float* listr, LAS unsigned* listT, const GAS f32x4* sak, int lane) {
    unsigned T = 0u;
    for (int bit = 31; bit >= 0; --bit) {
        const unsigned cand = T | (1u << bit);
        int c = 0;
#pragma unroll
        for (int rr = 0; rr < 32; ++rr) c += __builtin_popcountll(__builtin_amdgcn_ballot_w64(uk[rr] >= cand));
        if (c >= 256) T = cand;
        if (c == 256) break;
    }
    int cgt = 0;
#pragma unroll
    for (int rr = 0; rr < 32; ++rr) cgt += __builtin_popcountll(__builtin_amdgcn_ballot_w64(uk[rr] > T));
    const int need_eq = 256 - cgt;
    int base = 0, eqseen = 0;
#pragma unroll
    for (int rr = 0; rr < 32; ++rr) {
        const bool gt = uk[rr] > T, eq = uk[rr] == T;
        const unsigned long long meq = __builtin_amdgcn_ballot_w64(eq);
        const int erank = eqseen + (int)__builtin_amdgcn_mbcnt_hi((unsigned)(meq >> 32), __builtin_amdgcn_mbcnt_lo((unsigned)meq, 0u));
        const bool sel = gt || (eq && erank < need_eq);
        const unsigned long long ms = __builtin_amdgcn_ballot_w64(sel);
        const int pos = base + (int)__builtin_amdgcn_mbcnt_hi((unsigned)(ms >> 32), __builtin_amdgcn_mbcnt_lo((unsigned)ms, 0u));
        if (sel) { list[pos] = 64 * rr + lane; listT[((pos >> 5) * 4 + (pos & 3)) * 8 + ((pos >> 2) & 7)] = (unsigned)(64 * rr + lane) * 512u; }
        base += __builtin_popcountll(ms); eqseen += __builtin_popcountll(meq);
    }
}

__device__ __forceinline__ void att_core(LAS unsigned char* Vst, const LAS float* listr, const LAS unsigned* listT, const bf16* P, const bf16* AKVb, bf16* ACAT, const float* aqg, size_t tok, int cnt, int lane) {
    const int fr = lane & 15, fq = lane >> 4;
    const GAS unsigned char* kbase = (const GAS unsigned char*)AKVb + fr * 16;
    const LAS unsigned* lt = listT + fq * 8;
    u32x4 kb[3][8];
#pragma unroll
    for (int s2 = 0; s2 < 3; ++s2) {
        const u32x4 o0 = *(const LAS u32x4*)(lt + s2 * 32), o1 = *(const LAS u32x4*)(lt + s2 * 32 + 4);
#pragma unroll
        for (int i = 0; i < 8; ++i) kb[s2][i] = *(const GAS u32x4*)(kbase + (i < 4 ? o0[i & 3] : o1[i & 3]));
    }
    bf16x8 Qf[4];
    {
        u32x4 raw[4]; float ss = 0.f;
#pragma unroll
        for (int kk = 0; kk < 4; ++kk) { raw[kk] = *(const GAS u32x4*)(P + tok * NP + C_AQ + fr * 128 + 32 * kk + 8 * fq);
#pragma unroll
            for (int e = 0; e < 4; ++e) { const float lo = bflo(raw[kk][e]), hi = bfhi(raw[kk][e]); ss += lo * lo + hi * hi; } }
        ss += __shfl_xor(ss, 16); ss += __shfl_xor(ss, 32);
        const float rq = rsqrtf(ss * (1.f / 128.f) + EPS) * (0.08838834764831845f * LOG2E);
#pragma unroll
        for (int kk = 0; kk < 4; ++kk) { const f32x4 g0 = *(const GAS f32x4*)(aqg + 32 * kk + 8 * fq), g1 = *(const GAS f32x4*)(aqg + 32 * kk + 8 * fq + 4); u32x4 o;
            o.x = pk2(bflo(raw[kk].x) * rq * g0.x, bfhi(raw[kk].x) * rq * g0.y); o.y = pk2(bflo(raw[kk].y) * rq * g0.z, bfhi(raw[kk].y) * rq * g0.w);
            o.z = pk2(bflo(raw[kk].z) * rq * g1.x, bfhi(raw[kk].z) * rq * g1.y); o.w = pk2(bflo(raw[kk].w) * rq * g1.z, bfhi(raw[kk].w) * rq * g1.w);
            Qf[kk] = __builtin_bit_cast(bf16x8, o); }
    }
    f32x4 lg[16];
    float mx = -INFINITY;
#pragma unroll
    for (int st = 0; st < 8; ++st) {
#pragma unroll
        for (int i = 0; i < 8; ++i) *(LAS u32x4*)(Vst + (4 * i + fq) * 272 + fr * 16) = kb[st % 3][i];
        __builtin_amdgcn_fence(__ATOMIC_RELEASE, "wavefront"); __builtin_amdgcn_wave_barrier();
        bf16x8 Kf[2][4];
#pragma unroll
        for (int gg = 0; gg < 2; ++gg)
#pragma unroll
            for (int kk = 0; kk < 4; ++kk) Kf[gg][kk] = *(const LAS bf16x8*)(Vst + (16 * gg + fr) * 272 + kk * 64 + fq * 16);
        const f32x4 lr0 = *(const LAS f32x4*)(listr + 32 * st + 4 * fq), lr1 = *(const LAS f32x4*)(listr + 32 * st + 16 + 4 * fq);
        if (st + 3 < 8) {
            const u32x4 o0 = *(const LAS u32x4*)(lt + (st + 3) * 32), o1 = *(const LAS u32x4*)(lt + (st + 3) * 32 + 4);
#pragma unroll
            for (int i = 0; i < 8; ++i) kb[st % 3][i] = *(const GAS u32x4*)(kbase + (i < 4 ? o0[i & 3] : o1[i & 3]));
        }
        __builtin_amdgcn_sched_barrier(0);
#pragma unroll
        for (int gg = 0; gg < 2; ++gg) {
            const int g = 2 * st + gg;
            f32x4 a = (f32x4){0.f, 0.f, 0.f, 0.f};
#pragma unroll
            for (int kk = 0; kk < 4; ++kk) a = mfma16(Kf[gg][kk], Qf[kk], a);
            const f32x4 lr = gg ? lr1 : lr0;
#pragma unroll
            for (int r = 0; r < 4; ++r) lg[g][r] = (16 * g + 4 * fq + r < cnt) ? a[r] * lr[r] : -INFINITY;
            mx = fmaxf(mx, fmaxf(fmaxf(lg[g][0], lg[g][1]), fmaxf(lg[g][2], lg[g][3])));
        }
        __builtin_amdgcn_fence(__ATOMIC_RELEASE, "wavefront"); __builtin_amdgcn_wave_barrier();
        __builtin_amdgcn_sched_barrier(0);
    }
    u32x4 vb[3][8];
#pragma unroll
    for (int s2 = 0; s2 < 3; ++s2) {
        const u32x4 o0 = *(const LAS u32x4*)(lt + s2 * 32), o1 = *(const LAS u32x4*)(lt + s2 * 32 + 4);
#pragma unroll
        for (int i = 0; i < 8; ++i) vb[s2][i] = *(const GAS u32x4*)(kbase + 256 + (i < 4 ? o0[i & 3] : o1[i & 3]));
    }
    mx = fmaxf(mx, __shfl_xor(mx, 16)); mx = fmaxf(mx, __shfl_xor(mx, 32));
    float sum = 0.f;
#pragma unroll
    for (int g = 0; g < 16; ++g)
#pragma unroll
        for (int r = 0; r < 4; ++r) { const float pz = __builtin_amdgcn_exp2f(lg[g][r] - mx); lg[g][r] = pz; sum += pz; }
    sum += __shfl_xor(sum, 16); sum += __shfl_xor(sum, 32);
    bf16x8 Pf[8];
#pragma unroll
    for (int G = 0; G < 8; ++G) { u32x4 t; t.x = pk2(lg[2 * G][0], lg[2 * G][1]); t.y = pk2(lg[2 * G][2], lg[2 * G][3]); t.z = pk2(lg[2 * G + 1][0], lg[2 * G + 1][1]); t.w = pk2(lg[2 * G + 1][2], lg[2 * G + 1][3]); Pf[G] = __builtin_bit_cast(bf16x8, t); }
    f32x4 O[8];
#pragma unroll
    for (int nb = 0; nb < 8; ++nb) O[nb] = (f32x4){0.f, 0.f, 0.f, 0.f};
    const LAS unsigned char* vbse = Vst + (4 * fq + (fr >> 2)) * 288 + (4 * (fr & 3)) * 2;
#pragma unroll
    for (int G = 0; G < 8; ++G) {
#pragma unroll
        for (int i = 0; i < 8; ++i) *(LAS u32x4*)(Vst + (4 * i + fq) * 288 + fr * 16) = vb[G % 3][i];
        __builtin_amdgcn_fence(__ATOMIC_RELEASE, "wavefront"); __builtin_amdgcn_wave_barrier();
        s16x4 tc[2][2], tn[2][2];
#pragma unroll
        for (int u = 0; u < 2; ++u) { tc[u][0] = ldtr((LAS unsigned char*)vbse + 32 * u); tc[u][1] = ldtr((LAS unsigned char*)vbse + 16 * 288 + 32 * u); }
        if (G + 3 < 8) {
            const u32x4 o0 = *(const LAS u32x4*)(lt + (G + 3) * 32), o1 = *(const LAS u32x4*)(lt + (G + 3) * 32 + 4);
#pragma unroll
            for (int i = 0; i < 8; ++i) vb[G % 3][i] = *(const GAS u32x4*)(kbase + 256 + (i < 4 ? o0[i & 3] : o1[i & 3]));
        }
#pragma unroll
        for (int np = 0; np < 4; ++np) {
            if (np + 1 < 4) {
#pragma unroll
                for (int u = 0; u < 2; ++u) { tn[u][0] = ldtr((LAS unsigned char*)vbse + 32 * (2 * (np + 1) + u)); tn[u][1] = ldtr((LAS unsigned char*)vbse + 16 * 288 + 32 * (2 * (np + 1) + u)); } }
            __builtin_amdgcn_sched_barrier(0);
#pragma unroll
            for (int u = 0; u < 2; ++u) O[2 * np + u] = mfma16(__builtin_shufflevector(tc[u][0], tc[u][1], 0, 1, 2, 3, 4, 5, 6, 7), Pf[G], O[2 * np + u]);
            __builtin_amdgcn_sched_barrier(0);
            if (np + 1 < 4) {
#pragma unroll
                for (int u = 0; u < 2; ++u) { tc[u][0] = tn[u][0]; tc[u][1] = tn[u][1]; } }
        }
        __builtin_amdgcn_fence(__ATOMIC_RELEASE, "wavefront"); __builtin_amdgcn_wave_barrier();
        __builtin_amdgcn_sched_barrier(0);
    }
    const float rs = __builtin_amdgcn_rcpf(sum);
    LAS float* Ot = (LAS float*)Vst;
#pragma unroll
    for (int nb = 0; nb < 8; ++nb) *(LAS f32x4*)(Ot + fr * 132 + 16 * nb + 4 * fq) = O[nb] * rs;
    __builtin_amdgcn_fence(__ATOMIC_RELEASE, "wavefront"); __builtin_amdgcn_wave_barrier();
    {
        u32x2 sg[8];
#pragma unroll
        for (int j = 0; j < 8; ++j) sg[j] = *(const GAS u32x2*)(P + tok * NP + C_AG + 256 * j + 4 * lane);
#pragma unroll
        for (int j = 0; j < 8; ++j) {
            const int c = 256 * j + 4 * lane;
            const f32x4 o4 = *(const LAS f32x4*)(Ot + (c >> 7) * 132 + (c & 127));
            u32x2 o; o.x = pk2(o4.x * bflo(sg[j].x), o4.y * bfhi(sg[j].x)); o.y = pk2(o4.z * bflo(sg[j].y), o4.w * bfhi(sg[j].y));
            *(GAS u32x2*)(ACAT + ((size_t)NTOK + tok) * DM + c) = o;
        }
    }
    __builtin_amdgcn_fence(__ATOMIC_RELEASE, "wavefront"); __builtin_amdgcn_wave_barrier();
}

__device__ __forceinline__ void att_unit(LAS unsigned char* lds, const bf16* P, const bf16* AKV, const bf16* IKC, bf16* ACAT, const float* aqg, const float* ssq_ak, const float* ssq_ik, int b, int qg, int tid) {
    asm volatile("" : "+s"(P), "+s"(AKV), "+s"(IKC), "+s"(ACAT), "+s"(aqg), "+s"(ssq_ak), "+s"(ssq_ik), "+s"(qg), "+v"(tid));
    const int lane = tid & 63, w = __builtin_amdgcn_readfirstlane(tid >> 6), fr = lane & 15, fq = lane >> 4;
    LAS unsigned char* IK = lds;
    LAS unsigned char* Vst = lds + w * 9216;
    LAS int* list0 = (LAS int*)(lds + 73728 + w * 6144);
    const int L = 64 * ((qg >> 2) + 1);
    const bf16* AKVb = AKV + (size_t)(b * SEQ) * 256;
    const bf16* IKb = IKC + (size_t)(b * SEQ) * 128;
    const GAS f32x4* sak = (const GAS f32x4*)ssq_ak + b * SEQ;
    const size_t tok0 = (size_t)(b * SEQ + 16 * qg + 2 * w);
    int cnt;
    if (L <= 256) {
        cnt = L;
#pragma unroll
        for (int r = 0; r < 4; ++r) { const int i = 64 * r + lane; const int kx = i < L ? i : 0; const f32x4 q4 = sak[kx]; const float rk = rsqrtf(((q4.x + q4.y) + (q4.z + q4.w)) * (1.f / 128.f) + EPS);
            list0[i] = kx; ((LAS float*)list0)[256 + i] = rk; list0[512 + i] = kx; ((LAS float*)list0)[768 + i] = rk;
            const int tp = ((i >> 5) * 4 + (i & 3)) * 8 + ((i >> 2) & 7); ((LAS unsigned*)list0)[1024 + tp] = (unsigned)kx * 512u; ((LAS unsigned*)list0)[1280 + tp] = (unsigned)kx * 512u; }
    } else {
        cnt = 256;
        typedef float f32x2 __attribute__((ext_vector_type(2)));
        const GAS f32x2* sik = (const GAS f32x2*)ssq_ik + b * SEQ;
        bf16x8 Qi[2][2]; float wv[2][4];
#pragma unroll
        for (int q = 0; q < 2; ++q) {
#pragma unroll
            for (int kk = 0; kk < 2; ++kk) Qi[q][kk] = *(const GAS bf16x8*)(P + (tok0 + q) * NP + C_IQ + fr * 64 + 32 * kk + 8 * fq);
            const u32x2 ww = *(const GAS u32x2*)(IKC + (tok0 + q) * 128 + 64 + 4 * fq); wv[q][0] = bflo(ww.x); wv[q][1] = bfhi(ww.x); wv[q][2] = bflo(ww.y); wv[q][3] = bfhi(ww.y);
        }
        unsigned uk[2][32];
        const int ntile = (L + 255) >> 8;
        const int skey = tid >> 3, spart = tid & 7;
        const bf16* sb = IKb + (size_t)skey * 128 + spart * 8;
        u32x4 ikr[4]; f32x2 rik[4];
#pragma unroll
        for (int i = 0; i < 4; ++i) { ikr[i] = *(const GAS u32x4*)(sb + (size_t)(64 * i) * 128); rik[i] = sik[64 * i + lane]; }
#pragma unroll
        for (int i = 0; i < 4; ++i) *(LAS u32x4*)(IK + (skey + 64 * i) * 144 + spart * 16) = ikr[i];
        __syncthreads();
#pragma unroll
        for (int tile = 0; tile < 8; ++tile) {
            if (tile < ntile) {
                LAS unsigned char* IKc = IK + (tile & 1) * 36864;
                f32x2 rc[4];
#pragma unroll
                for (int i = 0; i < 4; ++i) rc[i] = rik[i];
                if (tile + 1 < ntile) {
#pragma unroll
                    for (int i = 0; i < 4; ++i) { ikr[i] = *(const GAS u32x4*)(sb + (size_t)(256 * (tile + 1) + 64 * i) * 128); rik[i] = sik[256 * (tile + 1) + 64 * i + lane]; }
                }
#pragma unroll
                for (int r4 = 0; r4 < 4; ++r4) {
                    float pt[2][4];
#pragma unroll
                    for (int q4 = 0; q4 < 4; ++q4) {
                        const LAS unsigned char* kp = IKc + (64 * r4 + 16 * q4 + fr) * 144 + fq * 16;
                        const bf16x8 K0 = *(const LAS bf16x8*)kp, K1 = *(const LAS bf16x8*)(kp + 64);
#pragma unroll
                        for (int q = 0; q < 2; ++q) {
                            f32x4 a = (f32x4){0.f, 0.f, 0.f, 0.f};
                            a = mfma16(Qi[q][0], K0, a); a = mfma16(Qi[q][1], K1, a);
                            pt[q][q4] = fmaxf(a[0], 0.f) * wv[q][0] + fmaxf(a[1], 0.f) * wv[q][1] + fmaxf(a[2], 0.f) * wv[q][2] + fmaxf(a[3], 0.f) * wv[q][3];
                        }
                    }
                    const int rr = 4 * tile + r4;
                    const float rscale = rsqrtf((rc[r4].x + rc[r4].y) * (1.f / 64.f) + EPS);
                    const bool live = 64 * rr + lane < L;
#pragma unroll
                    for (int q = 0; q < 2; ++q) {
                        float hx; const float A = half_sum32(pt[q][0], pt[q][2], hx), B = half_sum32(pt[q][1], pt[q][3], hx);
                        const bool odd = fq & 1;
                        const float send = odd ? A : B, keep = odd ? B : A;
                        const float sc = live ? (keep + __shfl_xor(send, 16)) * rscale : -INFINITY;
                        const unsigned bts = __float_as_uint(sc);
                        uk[q][rr] = bts ^ ((unsigned)((int)bts >> 31) | 0x80000000u);
                    }
                }
                if (tile + 1 < ntile) {
#pragma unroll
                    for (int i = 0; i < 4; ++i) *(LAS u32x4*)(IK + ((tile + 1) & 1) * 36864 + (skey + 64 * i) * 144 + spart * 16) = ikr[i];
                }
                __syncthreads();
            } else {
#pragma unroll
                for (int r4 = 0; r4 < 4; ++r4) { uk[0][4 * tile + r4] = 0x007fffffu; uk[1][4 * tile + r4] = 0x007fffffu; }
            }
        }
        topk_list(uk[0], list0, (LAS float*)list0 + 256, (LAS unsigned*)list0 + 1024, sak, lane);
        topk_list(uk[1], list0 + 512, (LAS float*)list0 + 768, (LAS unsigned*)list0 + 1280, sak, lane);
        __builtin_amdgcn_fence(__ATOMIC_RELEASE, "wavefront"); __builtin_amdgcn_wave_barrier();
        f32x4 q4[2][4];
#pragma unroll
        for (int q = 0; q < 2; ++q)
#pragma unroll
            for (int i = 0; i < 4; ++i) q4[q][i] = sak[list0[512 * q + 64 * i + lane]];
#pragma unroll
        for (int q = 0; q < 2; ++q)
#pragma unroll
            for (int i = 0; i < 4; ++i) ((LAS float*)list0)[512 * q + 256 + 64 * i + lane] = rsqrtf(((q4[q][i].x + q4[q][i].y) + (q4[q][i].z + q4[q][i].w)) * (1.f / 128.f) + EPS);
    }
    __syncthreads();
#pragma unroll 1
#ifndef REP_ATTB
#define REP_ATTB 1
#endif
    for (int q = 0; q < 2 * REP_ATTB; ++q)
        att_core(Vst, (const LAS float*)list0 + 512 * (q & 1) + 256, (const LAS unsigned*)list0 + 1024 + 256 * (q & 1), P, AKVb, ACAT, aqg, tok0 + (q & 1), cnt, lane);
}


struct Params { const float* in[10]; float* out; unsigned char* ws; };

__global__ void __launch_bounds__(512, 2) mega_fwd(Params p) {
    extern __shared__ __attribute__((aligned(16))) unsigned char lds_raw[];
    LAS unsigned char* lds = (LAS unsigned char*)lds_raw;
    cg::grid_group grid = cg::this_grid();
    const int tid = threadIdx.x, lane = tid & 63, wave = __builtin_amdgcn_readfirstlane(tid >> 6);
    const int G = gridDim.x, bx = blockIdx.x;
    const int gw = bx * 8 + wave, NGW = G * 8;
    unsigned char* ws = p.ws;
    if (tid < 8) ((LAS unsigned*)(lds + LDS_WQ_OFF))[16 + tid] = 0u;
    __syncthreads();
    (void)xcd_barrier_post((unsigned*)(ws + CTL_XBAR), (volatile LAS unsigned*)(lds + LDS_WQ_OFF + 64));
    grid.sync();
#ifdef REP_BAR
#define GSYNC() do { _Pragma("unroll 1") for (int rb_ = 0; rb_ < 2; ++rb_) GSYNC1(); } while (0)
#else
#define GSYNC() GSYNC1()
#endif
#define GSYNC1() do { unsigned char* wsb = p.ws; asm volatile("" : "+s"(wsb)); XcdBarrier xb_; xb_.bar = (unsigned*)(wsb + CTL_XBAR); xb_.x = xb_xcc_id(); xb_.st = (volatile LAS unsigned*)(lds + LDS_WQ_OFF + 64); xcd_barrier(xb_); } while (0)
#define LAUNDER() unsigned char* wsl = ws; asm volatile("" : "+s"(wsl)); bf16* XN = (bf16*)(wsl + WS_XN); bf16* Pm = (bf16*)(wsl + WS_P); bf16* ACAT = (bf16*)(wsl + WS_ACAT); float* G1 = (float*)(wsl + WS_G1); bf16* MB = (bf16*)(wsl + WS_MB); \
    const float* cosT = (const float*)(wsl + WS_TAB); const float* sinT = cosT + 2048 * 128; float* ssq_ak = (float*)(wsl + WS_SSQ); float* ssq_ik = ssq_ak + (size_t)NTOK * 4; bf16* AKV = (bf16*)(wsl + WS_AKV); bf16* IKC = (bf16*)(wsl + WS_IKC); bf16* RQKV = (bf16*)(wsl + WS_RQKV); (void)AKV; (void)IKC; (void)RQKV; \
    (void)XN; (void)Pm; (void)ACAT; (void)G1; (void)MB; (void)cosT; (void)sinT; (void)ssq_ak; (void)ssq_ik;

#ifndef PH
#define PH 31
#endif
#if PH & 1
#ifndef REP_P0
#define REP_P0 1
#endif
#pragma unroll 1
    for (int r0 = 0; r0 < REP_P0; ++r0) { __syncthreads(); p0_phase(p.in, ws, lds, gw, NGW, wave, lane, bx * 512 + tid, G * 512); }
#endif
    GSYNC();

    for (int l = 0; l < DEPTH; ++l) {
#if PH & 2
        {
            LAUNDER();
            pg8::Gemm g{XN, (const bf16*)(wsl + WS_WIN + l * WIN_L), NTOK, NP, DM};
            pg8::StaticOrder S; S.init(NTOK, NP, G, bx);
            int rbase;
            { pg8::Unit u0; int pmin = 1 << 30, pmax = -1; for (int i = 0; S.next(i, u0); ++i) { pmin = u0.pm < pmin ? u0.pm : pmin; pmax = u0.pm > pmax ? u0.pm : pmax; }
              if (pmax < 0) { pmin = 0; pmax = 0; }
              rbase = pmin * 256; const int nrw = (pmax - pmin + 1) * 256 < 2048 ? (pmax - pmin + 1) * 256 : 2048;
              LAS float* rt = (LAS float*)(lds + LDS_RTAB_OFF); const GAS f32x4* RSv = (const GAS f32x4*)(wsl + WS_RS);
              int tidl = tid; asm volatile("" : "+v"(tidl));
#pragma unroll 1
              for (int j = 0; j < 4; ++j) { const int rrow = tidl + 512 * j; if (rrow >= nrw) break; const GAS f32x4* rp = RSv + (size_t)(rbase + rrow) * 8; float sm = 0.f;
#pragma unroll
                  for (int e = 0; e < 8; ++e) { const f32x4 t4 = rp[e]; sm += (t4.x + t4.y) + (t4.z + t4.w); }
                  rt[rrow] = rsqrtf(sm * (1.f / DM) + EPS); }
              __syncthreads(); }
            EpiP E{Pm, cosT, sinT, p.in[5] + l * 128, p.in[6] + l * 64, ssq_ak, ssq_ik, AKV, IKC, RQKV, (const LAS float*)(lds + LDS_RTAB_OFF), rbase};
#ifndef REP_GEMM
#define REP_GEMM 1
#endif
#pragma unroll 1
            for (int rg = 0; rg < REP_GEMM; ++rg) { __syncthreads(); pg8::gemm_phase<EpiP, pg8::StaticOrder, true, true>(lds, g, S, E); }
            if (l + 1 < DEPTH) { int tidc = tid; asm volatile("" : "+v"(tidc)); conv_drain(p.in, wsl, lds, l + 1, tidc); }
        }
#endif
        GSYNC();
#if PH & 4
        {
            LAUNDER();
#ifndef REP_P2
#define REP_P2 1
#endif
            LAS int* wq = (LAS int*)(lds + LDS_WQ_OFF);
            const float* rog = p.in[3] + l * 2048; const float* aqg = p.in[4] + l * 128;
            const int hb = (int)((xb_xcc_id() >> 1) & 3u);
#pragma unroll 1
            for (int sb = 0; sb < 4; ++sb) {
                const int b = (hb + sb) & 3;
                unsigned* ctr = (unsigned*)(wsl + CTL_WQ + 1024 * l + 256 * b);
                const bf16* TS = (const bf16*)(wsl + WS_TS);
                for (;;) {
                    __syncthreads();
                    if (tid == 0) wq[0] = (int)atomicAdd(ctr, 1u);
                    __syncthreads();
                    const int u = __builtin_amdgcn_readfirstlane(wq[0]);
                    if (u >= 288) break;
                    int kind, a0 = 0, a1 = 0;
                    if (u < 32) { kind = 0; a0 = u >> 2; a1 = u & 3; }
                    else if (u < 96) { kind = 1; a0 = 127 - (u - 32); }
                    else { const int v = u - 96, v3 = v / 3, vr = v - 3 * v3;
                        if (vr == 0) { kind = 1; a0 = 63 - v3; } else { const int k = 2 * v3 + (vr - 1); kind = 2; a0 = k & 7; a1 = 15 - (k >> 3); } }
                    unsigned* flagp = (unsigned*)(wsl + CTL_FLAG) + ((l * 4 + b) * 8 + a0) * 16;
                    if (kind == 1) {
#ifndef NO_ATT
                        att_unit(lds, Pm, AKV, IKC, ACAT, aqg, ssq_ak, ssq_ik, b, a0, tid);
#endif
                    } else if (kind == 2) {
#ifndef NO_RET
                        ret_unit(lds, Pm, RQKV, TS, flagp, ACAT, rog, b, a0, a1, tid);
#endif
                    } else {
                        state_unit(lds, RQKV, (bf16*)TS, flagp, b, a0, a1, tid);
                    }
                }
            }
        }
#endif
        GSYNC();
#if PH & 8
        {
            LAUNDER();
            pg8::Gemm g{ACAT, (const bf16*)(wsl + WS_WBR + l * WBR_L), 2 * NTOK, 4096, DM};
            BrOrder S{G, bx};
            EpiBr E{Pm, G1, MB};
#pragma unroll 1
            for (int rg = 0; rg < REP_GEMM; ++rg) { __syncthreads(); pg8::gemm_phase<EpiBr, BrOrder, true, true>(lds, g, S, E); }
        }
#endif
        GSYNC();
#if PH & 16
        {
            LAUNDER();
            pg8::Gemm g{MB, (const bf16*)(wsl + WS_WOUT + l * WOUT_L), NTOK, DM, DM};
            pg8::StaticOrder S; S.init(NTOK, DM, G, bx);
            float* outl = p.out; const float* xol = l == 0 ? p.in[0] : (const float*)p.out; asm volatile("" : "+s"(outl), "+s"(xol));
            EpiOut E{xol, outl, l + 1 < DEPTH ? XN : (bf16*)nullptr, (float*)(wsl + WS_RS)};
            pg8::gemm_phase<EpiOut, pg8::StaticOrder, true, true>(lds, g, S, E);
        }
#endif
        if (l + 1 < DEPTH) GSYNC();
    }
}

extern "C" void kernel_launch(void* const* d_in, const int* in_sizes, int n_in, void* d_out, int out_size, void* d_ws, size_t ws_size, hipStream_t stream) {
    static int grid = 0;
    if (grid == 0) {
        if (n_in != 10 || out_size != NTOK * DM || ws_size < WS_END) { fprintf(stderr, "kernel_launch: unexpected shapes (n_in %d out %d ws %zu need %zu)\n", n_in, out_size, ws_size, (size_t)WS_END); grid = -1; return; }
        int dev = 0, cus = 0, per_cu = 0;
        hipGetDevice(&dev);
        hipDeviceGetAttribute(&cus, hipDeviceAttributeMultiprocessorCount, dev);
        if (hipFuncSetAttribute((const void*)mega_fwd, hipFuncAttributeMaxDynamicSharedMemorySize, LDS_BYTES) != hipSuccess) { fprintf(stderr, "kernel_launch: hipFuncSetAttribute failed\n"); grid = -1; return; }
        if (hipOccupancyMaxActiveBlocksPerMultiprocessor(&per_cu, (const void*)mega_fwd, 512, LDS_BYTES) != hipSuccess || per_cu < 1) { fprintf(stderr, "kernel_launch: occupancy query gave %d\n", per_cu); per_cu = 1; }
        (void)hipGetLastError();
        grid = cus * per_cu;
    }
    if (grid < 0) return;
    hipMemsetAsync((char*)d_ws + WS_CTL, 0, CTL_BYTES, stream);
    Params p{};
    for (int i = 0; i < 10; ++i) p.in[i] = (const float*)d_in[i];
    p.out = (float*)d_out; p.ws = (unsigned char*)d_ws;
    void* args[] = {&p};
    hipError_t e = hipLaunchCooperativeKernel((const void*)mega_fwd, dim3(grid), dim3(512), args, LDS_BYTES, stream);
    if (e != hipSuccess) fprintf(stderr, "cooperative launch failed: %s (grid %d)\n", hipGetErrorString(e), grid);
}
```

```cpp
#include <hip/hip_runtime.h>
#include <cstdio>
#include <cstdint>
namespace pg8 {
#define PG8_LAS __attribute__((address_space(3)))
typedef unsigned short bf16_t;
typedef short bf16x8 __attribute__((ext_vector_type(8)));
typedef float f32x4 __attribute__((ext_vector_type(4)));
typedef unsigned u32x4 __attribute__((ext_vector_type(4)));
constexpr int BM = 256, BK = 64, HALF = 128, HTB = HALF * BK * 2  , STAGE_BYTES = 8 * HTB, NXCD = 8, WGM = 8;

__host__ __device__ __forceinline__ int lds_byte(int r, int c) { const int st = (r >> 4) * 2 + (c >> 5), rr = r & 15, cc = c & 31, ob = rr * 64 + cc * 2; return st * 1024 + (ob ^ (((ob >> 9) & 1) << 5)); }
__host__ __device__ __forceinline__ void stage_rc(int b, int& R, int& C) { const int st = b / 1024, sb = b % 1024, swz = sb ^ (((sb >> 9) & 1) << 5); R = (st >> 1) * 16 + swz / 64; C = (st & 1) * 32 + (swz % 64) / 2; }
__host__ __device__ __forceinline__ int perm32(int rho) { const int n = rho >> 4, i = rho & 15; return 8 * (i >> 2) + 4 * n + (i & 3); }

struct Unit { int pm, pn; };
struct Gemm { const bf16_t* A; const bf16_t* Bt; int M, N, K; };

struct StaticOrder {
    int nM, nN, nwg, G, c;
    __host__ __device__ void init(int M, int N, int G_, int c_) { nM = M / BM; nN = N / BM; nwg = nM * nN; G = G_; c = c_; }
    __host__ __device__ bool next(int i, Unit& u) const {
        const long L = (long)i * G + c; if (L >= nwg) return false;
        int wgid = (int)L; { const int q = nwg / NXCD, r = nwg % NXCD, xcd = wgid % NXCD, off = wgid / NXCD; wgid = (xcd < r ? xcd * (q + 1) : r * (q + 1) + (xcd - r) * q) + off; }
        const int nig = WGM * nN, gid = wgid / nig, fm = gid * WGM, gsz = (nM - fm) < WGM ? (nM - fm) : WGM;
        u.pm = fm + ((wgid % nig) % gsz); u.pn = (wgid % nig) / gsz; return true;
    }
    __device__ __forceinline__ void a_ready(const Unit&) const {}
    __device__ __forceinline__ void done(const Unit&) const {}
};

__device__ __forceinline__ unsigned cvt_pk_bf16(float lo, float hi) { unsigned r; asm volatile("v_cvt_pk_bf16_f32 %0, %1, %2" : "=v"(r) : "v"(lo), "v"(hi)); return r; }
template <class Epi, class Sched, bool ALIGN_EPI = false, bool SP2 = false>
__device__ __forceinline__ void gemm_phase(PG8_LAS unsigned char* lds, const Gemm g, const Sched& S, const Epi& E) {
    int tid_ = threadIdx.x; asm volatile("" : "+v"(tid_));
    const int tid = tid_, wid = __builtin_amdgcn_readfirstlane(tid >> 6), lane = tid & 63, wr = wid >> 2, wc = wid & 3, fr = lane & 15, fq = lane >> 4;
    const int K = g.K, nt = K / BK;
    unsigned voffA[2], voffB[2];
#pragma unroll
    for (int i = 0; i < 2; ++i) { int R, C; stage_rc(tid * 16 + i * 8192, R, C); const int Rb = Epi::PERM ? ((R & ~31) + perm32(R & 31)) : R;
        voffA[i] = (unsigned)(R * K + C) * 2u; voffB[i] = (unsigned)(Rb * K + C) * 2u; }
    const size_t kstep = (size_t)(BK * 2);
    const size_t hstep = (size_t)HALF * K * 2;
    const size_t tstep = 2 * hstep;
    const unsigned ldsw = (unsigned)wid * 1024u;
    const int aoff = lds_byte(wr * 64 + fr, fq * 8), boff = lds_byte(wc * 32 + fr, fq * 8);
#define PG8_SA(b, h) (((b) * 2 + (h)) * HTB)
#define PG8_SB(b, h) ((4 + (b) * 2 + (h)) * HTB)
#define PG8_STAGE(bufoff, gbase, voff) do { _Pragma("unroll") for (int _i = 0; _i < 2; ++_i) \
        __builtin_amdgcn_global_load_lds((const unsigned*)((const char*)(gbase) + (voff)[_i]), (PG8_LAS unsigned*)(lds + (bufoff) + ldsw + _i * 8192), 16, 0, 0); } while (0)
#define PG8_LDA(dst, b, h) do { _Pragma("unroll") for (int m = 0; m < 4; ++m) _Pragma("unroll") for (int k = 0; k < 2; ++k) dst[m][k] = *(const PG8_LAS bf16x8*)(lds + PG8_SA(b, h) + aoff + m * 2048 + k * 1024); } while (0)
#define PG8_LDB(dst, b, h) do { _Pragma("unroll") for (int n = 0; n < 2; ++n) _Pragma("unroll") for (int k = 0; k < 2; ++k) dst[n][k] = *(const PG8_LAS bf16x8*)(lds + PG8_SB(b, h) + boff + n * 2048 + k * 1024); } while (0)
#define PG8_MMA(ai, bj, At, Bt) do { __builtin_amdgcn_s_setprio(1); _Pragma("unroll") for (int m = 0; m < 4; ++m) _Pragma("unroll") for (int n = 0; n < 2; ++n) _Pragma("unroll") for (int k = 0; k < 2; ++k) \
        acc[ai][bj][m][n] = __builtin_amdgcn_mfma_f32_16x16x32_bf16(Bt[n][k], At[m][k], acc[ai][bj][m][n], 0, 0, 0); __builtin_amdgcn_s_setprio(0); } while (0)
#define PG8_WAIT_V(n) asm volatile("s_waitcnt vmcnt(" #n ")" ::: "memory")
#define PG8_WAIT_L(n) asm volatile("s_waitcnt lgkmcnt(" #n ")" ::: "memory")
#define PG8_BAR __builtin_amdgcn_s_barrier()
#define PG8_SCHED __builtin_amdgcn_sched_barrier(0)
    Unit cur, nxt; int ui = 0;
    if (!S.next(0, cur)) return;
    f32x4 acc[2][2][4][2];
#pragma unroll
    for (int a = 0; a < 2; ++a)
#pragma unroll
        for (int b = 0; b < 2; ++b)
#pragma unroll
            for (int m = 0; m < 4; ++m)
#pragma unroll
                for (int n = 0; n < 2; ++n) acc[a][b][m][n] = (f32x4){0.f, 0.f, 0.f, 0.f};
    bf16x8 At[4][2], B0[2][2], B1[2][2];
    const char* cA = (const char*)g.A + (size_t)cur.pm * tstep; const char* cB = (const char*)g.Bt + (size_t)cur.pn * tstep;
    S.a_ready(cur);
    if constexpr (SP2) {
        PG8_STAGE(PG8_SB(0, 0), cB, voffB); PG8_STAGE(PG8_SB(0, 1), cB + hstep, voffB); PG8_STAGE(PG8_SA(0, 0), cA, voffA); PG8_STAGE(PG8_SA(0, 1), cA + hstep, voffA);
        if (wr == 1) PG8_BAR;
        PG8_WAIT_V(2); PG8_BAR;
        PG8_STAGE(PG8_SB(1, 0), cB + kstep, voffB); PG8_STAGE(PG8_SA(1, 0), cA + kstep, voffA); PG8_STAGE(PG8_SB(1, 1), cB + hstep + kstep, voffB);
        PG8_WAIT_V(6); PG8_BAR;
    } else {
        PG8_STAGE(PG8_SB(0, 0), cB, voffB); PG8_STAGE(PG8_SA(0, 0), cA, voffA); PG8_STAGE(PG8_SB(0, 1), cB + hstep, voffB); PG8_STAGE(PG8_SA(0, 1), cA + hstep, voffA);
        if (wr == 1) PG8_BAR;
        PG8_WAIT_V(4); PG8_BAR;
        PG8_STAGE(PG8_SB(1, 0), cB + kstep, voffB); PG8_STAGE(PG8_SA(1, 0), cA + kstep, voffA); PG8_STAGE(PG8_SB(1, 1), cB + hstep + kstep, voffB);
        PG8_WAIT_V(6); PG8_BAR;
    }
    for (;;) {
        const bool has_next = S.next(ui + 1, nxt);
        const char* nA = has_next ? (const char*)g.A + (size_t)nxt.pm * tstep : cA; const char* nB = has_next ? (const char*)g.Bt + (size_t)nxt.pn * tstep : cB;
        for (int t = 0; t < nt; t += 2) {
            const bool last = (t == nt - 2);
            const char* a1 = cA + (size_t)(t + 1) * kstep;
            const char* a2 = last ? nA : cA + (size_t)(t + 2) * kstep; const char* b2 = last ? nB : cB + (size_t)(t + 2) * kstep;
            const char* a3 = a2 + kstep; const char* b3 = b2 + kstep;
            if (last && has_next) S.a_ready(nxt);
            if constexpr (SP2) {
            PG8_LDB(B0, 0, 0); PG8_LDB(B1, 0, 1); PG8_SCHED; PG8_LDA(At, 0, 0); PG8_STAGE(PG8_SA(1, 1), a1 + hstep, voffA);
            PG8_WAIT_V(8); PG8_WAIT_L(0); PG8_BAR; PG8_MMA(0, 0, At, B0); PG8_MMA(0, 1, At, B1); PG8_BAR; PG8_SCHED;
            PG8_LDA(At, 0, 1); PG8_STAGE(PG8_SB(0, 0), b2, voffB); PG8_STAGE(PG8_SB(0, 1), b2 + hstep, voffB); PG8_STAGE(PG8_SA(0, 0), a2, voffA);
            PG8_WAIT_V(8); PG8_WAIT_L(0); PG8_BAR; PG8_MMA(1, 0, At, B0); PG8_MMA(1, 1, At, B1); PG8_BAR; PG8_SCHED;
            PG8_LDB(B0, 1, 0); PG8_LDB(B1, 1, 1); PG8_SCHED; PG8_LDA(At, 1, 0); PG8_STAGE(PG8_SA(0, 1), a2 + hstep, voffA);
            PG8_WAIT_V(8); PG8_WAIT_L(0); PG8_BAR; PG8_MMA(0, 0, At, B0); PG8_MMA(0, 1, At, B1); PG8_BAR; PG8_SCHED;
            PG8_LDA(At, 1, 1); PG8_STAGE(PG8_SB(1, 0), b3, voffB); PG8_STAGE(PG8_SB(1, 1), b3 + hstep, voffB); PG8_STAGE(PG8_SA(1, 0), a3, voffA);
            PG8_WAIT_V(8); PG8_WAIT_L(0); PG8_BAR; PG8_MMA(1, 0, At, B0); PG8_MMA(1, 1, At, B1); PG8_BAR; PG8_SCHED;
            } else {
            PG8_LDB(B0, 0, 0); PG8_SCHED; PG8_LDA(At, 0, 0); PG8_STAGE(PG8_SA(1, 1), a1 + hstep, voffA);
            PG8_WAIT_L(8); PG8_BAR; PG8_WAIT_L(0); PG8_MMA(0, 0, At, B0); PG8_BAR; PG8_SCHED;
            PG8_LDB(B1, 0, 1); PG8_STAGE(PG8_SB(0, 0), b2, voffB);
            PG8_BAR; PG8_WAIT_L(0); PG8_MMA(0, 1, At, B1); PG8_BAR;
            PG8_LDA(At, 0, 1); PG8_STAGE(PG8_SA(0, 0), a2, voffA);
            PG8_BAR; PG8_WAIT_L(0); PG8_MMA(1, 0, At, B0); PG8_BAR; PG8_SCHED;
            PG8_STAGE(PG8_SB(0, 1), b2 + hstep, voffB);
            PG8_WAIT_V(6); PG8_BAR; PG8_MMA(1, 1, At, B1); PG8_BAR;
            PG8_LDB(B0, 1, 0); PG8_SCHED; PG8_LDA(At, 1, 0); PG8_STAGE(PG8_SA(0, 1), a2 + hstep, voffA);
            PG8_WAIT_L(8); PG8_BAR; PG8_WAIT_L(0); PG8_MMA(0, 0, At, B0); PG8_BAR; PG8_SCHED;
            PG8_LDB(B1, 1, 1); PG8_STAGE(PG8_SB(1, 0), b3, voffB);
            PG8_BAR; PG8_WAIT_L(0); PG8_MMA(0, 1, At, B1); PG8_BAR;
            PG8_LDA(At, 1, 1); PG8_STAGE(PG8_SA(1, 0), a3, voffA);
            PG8_BAR; PG8_WAIT_L(0); PG8_MMA(1, 0, At, B0); PG8_BAR; PG8_SCHED;
            PG8_STAGE(PG8_SB(1, 1), b3 + hstep, voffB);
            PG8_WAIT_V(6); PG8_BAR; PG8_MMA(1, 1, At, B1); PG8_BAR;
            }
        }
        if constexpr (ALIGN_EPI) { if (wr == 0) PG8_BAR; }
        if constexpr (!Epi::AFTER_DRAIN) { E(acc, cur, wr, wc, fr, fq); S.done(cur); }
        if (!has_next) break;
#pragma unroll
        for (int a = 0; a < 2; ++a)
#pragma unroll
            for (int b = 0; b < 2; ++b)
#pragma unroll
                for (int m = 0; m < 4; ++m)
#pragma unroll
                    for (int n = 0; n < 2; ++n) acc[a][b][m][n] = (f32x4){0.f, 0.f, 0.f, 0.f};
        cur = nxt; cA = nA; cB = nB; ++ui;
        if constexpr (ALIGN_EPI) { if (wr == 1) PG8_BAR; }
    }
    PG8_WAIT_V(0);
    if constexpr (!ALIGN_EPI) { if (wr == 0) PG8_BAR; }
    PG8_BAR;
    if constexpr (Epi::AFTER_DRAIN) { E.fused(acc, cur, wr, wc, fr, fq, lds, wid, lane); S.done(cur); }
#undef PG8_SA
#undef PG8_SB
#undef PG8_STAGE
#undef PG8_LDA
#undef PG8_LDB
#undef PG8_MMA
#undef PG8_WAIT_V
#undef PG8_WAIT_L
#undef PG8_BAR
#undef PG8_SCHED
}
}
#include <hip/hip_cooperative_groups.h>
namespace cg = cooperative_groups;
#define LAS __attribute__((address_space(3)))
#define GAS __attribute__((address_space(1)))
typedef unsigned short bf16;
typedef short bf16x8 __attribute__((ext_vector_type(8)));
typedef short s16x4 __attribute__((ext_vector_type(4)));
typedef float f32x4 __attribute__((ext_vector_type(4)));
typedef unsigned u32x4 __attribute__((ext_vector_type(4)));
typedef unsigned u32x2 __attribute__((ext_vector_type(2)));

constexpr int DM = 2048, NBATCH = 4, SEQ = 2048, NTOK = NBATCH * SEQ, DEPTH = 4;
constexpr int NSRC = 17744, NP = 17920;
constexpr int C_RQ = 0, C_RK = 2048, C_RV = 4096, C_RG = 6144, C_AQ = 8192, C_AK = 10240, C_AV = 10368, C_AG = 10496,
              C_IQ = 12544, C_IK = 13568, C_IW = 13632, C_GA = 13824, C_GB = 15872;
constexpr float EPS = 1e-6f;
constexpr float LOG2E = 1.4426950408889634f;

constexpr size_t MiB = 1u << 20;
constexpr size_t WS_CTL = 0, CTL_BYTES = 1 * MiB;
constexpr size_t CTL_WQ = 0;
constexpr size_t CTL_XBAR = 512 * 1024;
constexpr size_t CTL_FLAG = 131072;
constexpr size_t CTL_SSQ = 65536;
constexpr size_t WS_TAB = 1 * MiB;
constexpr size_t WS_WIN = 4 * MiB;
constexpr size_t WIN_L = (size_t)NP * DM * 2;
constexpr size_t WS_WBR = WS_WIN + DEPTH * WIN_L;
constexpr size_t WBR_L = (size_t)4096 * DM * 2;
constexpr size_t WS_WOUT = WS_WBR + DEPTH * WBR_L;
constexpr size_t WOUT_L = (size_t)DM * DM * 2;
constexpr size_t WS_XN = WS_WOUT + DEPTH * WOUT_L;
constexpr size_t WS_P = WS_XN + (size_t)NTOK * DM * 2;
constexpr size_t WS_ACAT = WS_P + (size_t)NTOK * NP * 2;
constexpr size_t WS_G1 = WS_ACAT + (size_t)2 * NTOK * DM * 2;
constexpr size_t WS_MB = WS_G1 + (size_t)NTOK * DM * 4;
constexpr size_t WS_SSQ = WS_MB + (size_t)NTOK * DM * 2;
constexpr size_t WS_AKV = WS_SSQ + 1 * MiB;
constexpr size_t WS_IKC = WS_AKV + (size_t)NTOK * 256 * 2;
constexpr size_t WS_RQKV = WS_IKC + (size_t)NTOK * 128 * 2;
constexpr size_t RQKV_ONE = (size_t)NTOK * 2048 * 2;
constexpr size_t WS_RS = WS_RQKV + 3 * RQKV_ONE;
constexpr size_t WS_TS = WS_RS + (size_t)NTOK * 32 * 4;
constexpr size_t WS_END = WS_TS + (size_t)NBATCH * 8 * 8 * 256 * 256 * 2;

constexpr int LDS_BYTES = 147456;
constexpr int LDS_WQ_OFF = 140 * 1024;
constexpr int LDS_RTAB_OFF = 128 * 1024;

__device__ __forceinline__ float bf2f(unsigned short h) { return __uint_as_float((unsigned)h << 16); }
__device__ __forceinline__ float bflo(unsigned w) { return __uint_as_float(w << 16); }
__device__ __forceinline__ float bfhi(unsigned w) { return __uint_as_float(w & 0xffff0000u); }
__device__ __forceinline__ unsigned pk2(float lo, float hi) { unsigned r; asm("v_cvt_pk_bf16_f32 %0, %1, %2" : "=v"(r) : "v"(lo), "v"(hi)); return r; }
__device__ __forceinline__ float sigm(float v) { return __builtin_amdgcn_rcpf(1.f + __builtin_amdgcn_exp2f(-v * LOG2E)); }
__device__ __forceinline__ float wave_sum(float v) {
#pragma unroll
    for (int o = 1; o < 64; o <<= 1) v += __shfl_xor(v, o);
    return v;
}
__device__ __forceinline__ f32x4 mfma16(bf16x8 a, bf16x8 b, f32x4 c) { return __builtin_amdgcn_mfma_f32_16x16x32_bf16(a, b, c, 0, 0, 0); }
__device__ __forceinline__ s16x4 ldtr(LAS unsigned char* p) { return __builtin_amdgcn_ds_read_tr16_b64_v4i16((LAS s16x4*)p); }

struct ItemP { const float* src; bf16* dst; const float* gk; int ldw; int nvalid; };
__device__ __forceinline__ ItemP item_decode(const float* const* in, unsigned char* ws, int it) {
    constexpr int I_IN = 32 * 280, I_SQ = 32 * 32, I_L = I_IN + 3 * I_SQ;
    const int l = it / I_L; int r = it % I_L; ItemP p;
    if (r < I_IN) {
        const int kb = r / 280, db = r % 280;
        const int src_c0 = db <= 213 ? 64 * db : 64 * db - 176;
        p.nvalid = db < 213 ? 64 : (db == 213 ? 16 : (db < 216 ? 0 : 64));
        p.ldw = NSRC; p.src = in[2] + (size_t)l * DM * NSRC + (size_t)(64 * kb) * NSRC + src_c0;
        p.dst = (bf16*)(ws + WS_WIN + l * WIN_L) + (size_t)(64 * db) * DM + 64 * kb;
        p.gk = in[1] + l * DM + 64 * kb;
    } else {
        r -= I_IN; const int which = r / I_SQ; r %= I_SQ; const int kb = r / 32, db = r % 32;
        const float* W = (which == 0 ? in[7] : (which == 1 ? in[8] : in[9])) + (size_t)l * DM * DM;
        bf16* WT = which == 2 ? (bf16*)(ws + WS_WOUT + l * WOUT_L) : (bf16*)(ws + WS_WBR + l * WBR_L) + (size_t)which * DM * DM;
        p.gk = nullptr; p.nvalid = 64; p.ldw = DM; p.src = W + (size_t)(64 * kb) * DM + 64 * db; p.dst = WT + (size_t)(64 * db) * DM + 64 * kb;
    }
    return p;
}
__device__ __forceinline__ void item_load(const ItemP& p, f32x4 (&v)[16], int lane) {
    const int c4 = 4 * (lane & 15);
#pragma unroll
    for (int i = 0; i < 16; ++i) { v[i] = (f32x4){0.f, 0.f, 0.f, 0.f}; if (c4 < p.nvalid) v[i] = __builtin_nontemporal_load((const GAS f32x4*)(p.src + (size_t)(4 * i + (lane >> 4)) * p.ldw + c4)); }
    if (p.gk) {
#pragma unroll
        for (int i = 0; i < 16; ++i) v[i] = v[i] * p.gk[4 * i + (lane >> 4)]; }
}
__device__ __forceinline__ void item_store(const ItemP& p, const f32x4 (&v)[16], LAS float* scr, int lane) {
    const int c4 = 4 * (lane & 15);
#pragma unroll
    for (int i = 0; i < 16; ++i) { LAS float* d = scr + (4 * i + (lane >> 4)) * 65 + c4; d[0] = v[i].x; d[1] = v[i].y; d[2] = v[i].z; d[3] = v[i].w; }
    asm volatile("s_waitcnt lgkmcnt(0)" ::: "memory");
    const int c = lane & 7;
#pragma unroll
    for (int j = 0; j < 8; ++j) {
        const int n = 8 * j + (lane >> 3);
        const LAS float* s = scr + (8 * c) * 65 + n;
        u32x4 o; o.x = pk2(s[0], s[65]); o.y = pk2(s[2 * 65], s[3 * 65]); o.z = pk2(s[4 * 65], s[5 * 65]); o.w = pk2(s[6 * 65], s[7 * 65]);
        *(GAS u32x4*)(p.dst + (size_t)n * DM + 8 * c) = o;
    }
    asm volatile("s_waitcnt lgkmcnt(0)" ::: "memory");
}

__device__ __forceinline__ void cast_rows(const float* x, bf16* XN, float* RS, int gw, int NGW, int lane) {
    for (int m = gw; m < NTOK; m += NGW) {
        const GAS f32x4* xr = (const GAS f32x4*)(x + (size_t)m * DM) + lane;
        f32x4 v[8]; float s = 0.f;
#pragma unroll
        for (int j = 0; j < 8; ++j) { v[j] = xr[64 * j]; s += (v[j].x * v[j].x + v[j].y * v[j].y) + (v[j].z * v[j].z + v[j].w * v[j].w); }
        s = wave_sum(s);
        GAS u32x2* o = (GAS u32x2*)(XN + (size_t)m * DM) + lane;
#pragma unroll
        for (int j = 0; j < 8; ++j) { u32x2 w; w.x = pk2(v[j].x, v[j].y); w.y = pk2(v[j].z, v[j].w); o[64 * j] = w; }
        if (lane < 32) RS[(size_t)m * 32 + lane] = lane == 0 ? s : 0.f;
    }
}

__device__ __forceinline__ void p0_phase(const float* const* in, unsigned char* ws, LAS unsigned char* lds, int gw, int NGW, int wave, int lane, int gtid, int NGT) {
    float* rinv = (float*)(ws + WS_TAB);
    if (gtid < 128) rinv[gtid] = (float)(exp(-(double)gtid * (9.210340371976184 / 127.0)) * 0.15915494309189535);
    LAS float* scr = (LAS float*)(lds + wave * 16640);
    constexpr int N_ITEMS = 32 * 280 + 3 * 32 * 32;
    {
        f32x4 va[16], vb[16];
        int it = gw;
        ItemP pa = item_decode(in, ws, it < N_ITEMS ? it : 0), pb = pa;
        if (it < N_ITEMS) item_load(pa, va, lane);
        while (it < N_ITEMS) {
            const int itb = it + NGW;
            if (itb < N_ITEMS) { pb = item_decode(in, ws, itb); item_load(pb, vb, lane); }
            item_store(pa, va, scr, lane);
            if (itb >= N_ITEMS) break;
            const int ita = itb + NGW;
            if (ita < N_ITEMS) { pa = item_decode(in, ws, ita); item_load(pa, va, lane); }
            item_store(pb, vb, scr, lane);
            it = ita;
        }
    }
    cast_rows(in[0], (bf16*)(ws + WS_XN), (float*)(ws + WS_RS), gw, NGW, lane);
}

constexpr size_t CTL_CQ = 16384;
__device__ __forceinline__ void conv_drain(const float* const* in, unsigned char* ws, LAS unsigned char* lds, int layer, int tid) {
    constexpr int I_L = 32 * 280 + 3 * 32 * 32;
    unsigned* ctr = (unsigned*)(ws + CTL_CQ + 256 * layer);
    LAS int* wq = (LAS int*)(lds + LDS_WQ_OFF);
    const int lane = tid & 63, w = __builtin_amdgcn_readfirstlane(tid >> 6);
    LAS float* scr = (LAS float*)(lds + w * 16640);
    for (;;) {
        __syncthreads();
        if (tid == 0) wq[0] = (int)atomicAdd(ctr, 16u);
        __syncthreads();
        const int base = __builtin_amdgcn_readfirstlane(wq[0]);
        if (base >= I_L) break;
        f32x4 va[16], vb[16];
        const ItemP pa = item_decode(in, ws, layer * I_L + base + w), pb = item_decode(in, ws, layer * I_L + base + 8 + w);
        item_load(pa, va, lane); item_load(pb, vb, lane);
        item_store(pa, va, scr, lane); item_store(pb, vb, scr, lane);
    }
}

__device__ __forceinline__ float bperm_f(int src4, float v) { return __int_as_float(__builtin_amdgcn_ds_bpermute(src4, __float_as_int(v))); }
__device__ __forceinline__ unsigned bperm_u(int src4, unsigned v) { return (unsigned)__builtin_amdgcn_ds_bpermute(src4, (int)v); }
__device__ __forceinline__ f32x4 bperm_f4(int src4, f32x4 v) { return (f32x4){bperm_f(src4, v.x), bperm_f(src4, v.y), bperm_f(src4, v.z), bperm_f(src4, v.w)}; }
__device__ __forceinline__ u32x4 bperm_u4(int src4, u32x4 v) { u32x4 r; r.x = bperm_u(src4, v.x); r.y = bperm_u(src4, v.y); r.z = bperm_u(src4, v.z); r.w = bperm_u(src4, v.w); return r; }
struct EpiP {
    static constexpr bool PERM = true, AFTER_DRAIN = false;
    bf16* P; const float* cosT; const float* sinT; const float* akg; const float* ikg; float* ssq_ak; float* ssq_ik; bf16* AKV; bf16* IKC; bf16* RQKV; const LAS float* rtab; int rbase;
    __device__ __forceinline__ void operator()(const pg8::f32x4 (&acc)[2][2][4][2], const pg8::Unit& u, int wr, int wc, int fr, int fq) const {
        const int pn = u.pn;
        const int row0 = u.pm * 256 + wr * 64 + fr;
        const int cl = wc * 32 + 8 * fq;
        const int rowm0 = row0, clm = cl;
        int type;
        if (pn < 8) type = 1; else if (pn < 16) type = 2; else if (pn < 24) type = 0; else if (pn < 32) type = 3; else if (pn < 40) type = 0;
        else if (pn == 40) type = 5; else if (pn < 49) type = 3; else if (pn < 53) type = 0; else if (pn == 53) type = 6; else type = 4;
        f32x4 rv0 = (f32x4){0.f, 0.f, 0.f, 0.f}, rv1 = rv0;
        if (type == 1 || type == 2) { rv0 = *(const GAS f32x4*)(cosT + cl); rv1 = *(const GAS f32x4*)(cosT + cl + 4); }
#pragma unroll
        for (int ai = 0; ai < 2; ++ai)
#pragma unroll
            for (int m = 0; m < 4; ++m) {
                const int row = row0 + ai * 128 + m * 16;
                float a[8], b[8];
#pragma unroll
                for (int e = 0; e < 4; ++e) { a[e] = acc[ai][0][m][0][e]; a[4 + e] = acc[ai][0][m][1][e]; b[e] = acc[ai][1][m][0][e]; b[4 + e] = acc[ai][1][m][1][e]; }
                { const float rr = rtab[row - rbase];
#pragma unroll
                  for (int e = 0; e < 8; ++e) { a[e] *= rr; b[e] *= rr; } }
                if (type == 1 || type == 2) {
                    const float pos = (float)(row & 2047); const float sc = type == 2 ? 0.0625f : 1.f;
#pragma unroll
                    for (int e = 0; e < 8; ++e) { const float fx = __builtin_amdgcn_fractf(pos * (e < 4 ? rv0[e & 3] : rv1[e & 3]));
                        const float c = __builtin_amdgcn_cosf(fx) * sc, s = __builtin_amdgcn_sinf(fx) * sc; const float x1 = a[e], x2 = b[e]; a[e] = x1 * c - x2 * s; b[e] = x2 * c + x1 * s; }
                } else if (type == 3) {
#pragma unroll
                    for (int e = 0; e < 8; ++e) { a[e] = a[e] * sigm(a[e]); b[e] = b[e] * sigm(b[e]); }
                } else if (type == 4) {
#pragma unroll
                    for (int e = 0; e < 8; ++e) { a[e] = sigm(a[e]); b[e] = sigm(b[e]); }
                } else if (type == 5) {
                    float ss = 0.f;
#pragma unroll
                    for (int e = 0; e < 8; ++e) { ss += a[e] * a[e]; a[e] *= akg[cl + e]; }
                    ss += __shfl_xor(ss, 16); ss += __shfl_xor(ss, 32);
                    if (fq == 0) ((GAS float*)ssq_ak)[row * 4 + wc] = ss;
                } else if (type == 6) {
                    if (wc < 2) {
                        float ss = 0.f;
#pragma unroll
                        for (int e = 0; e < 8; ++e) { ss += a[e] * a[e]; a[e] *= ikg[cl + e]; }
                        ss += __shfl_xor(ss, 16); ss += __shfl_xor(ss, 32);
                        if (fq == 0) ((GAS float*)ssq_ik)[row * 2 + wc] = ss;
                    }
                }
                u32x4 w0, w1;
                w0.x = pk2(a[0], a[1]); w0.y = pk2(a[2], a[3]); w0.z = pk2(a[4], a[5]); w0.w = pk2(a[6], a[7]);
                w1.x = pk2(b[0], b[1]); w1.y = pk2(b[2], b[3]); w1.z = pk2(b[4], b[5]); w1.w = pk2(b[6], b[7]);
                const int rowm = rowm0 + ai * 128 + m * 16;
                bf16* rowp = P + (size_t)rowm * NP + pn * 256 + clm;
                if (type == 5) rowp = AKV + (size_t)rowm * 256 + clm;
                if (pn < 24) rowp = RQKV + (size_t)(pn >> 3) * (RQKV_ONE / 2) + ((size_t)(((rowm >> 11) * 8 + (pn & 7)) * 2048 + (rowm & 2047))) * 256 + clm;
                if (type == 6) { *(GAS u32x4*)(IKC + (size_t)rowm * 128 + clm) = w0; } else { *(GAS u32x4*)rowp = w0; *(GAS u32x4*)(rowp + 128) = w1; }
            }
    }
};

struct EpiBr {
    static constexpr bool PERM = true, AFTER_DRAIN = false;
    const bf16* P; float* G1; bf16* MB;
    __device__ __forceinline__ void operator()(const pg8::f32x4 (&acc)[2][2][4][2], const pg8::Unit& u, int wr, int wc, int fr, int fq) const {
        const bool att = u.pm >= 32;
        const int src4 = (16 * (fr & 3) + 4 * fq + (fr >> 2)) * 4;
        const int row0 = (u.pm & 31) * 256 + wr * 64 + 4 * fq + (fr >> 2), col0 = (u.pn & 7) * 256 + wc * 32 + 8 * (fr & 3);
        const int gcol = att ? C_GB : C_GA;
        if (!att) {
#pragma unroll
            for (int ai = 0; ai < 2; ++ai) {
                u32x4 gt[4][2];
#pragma unroll
                for (int m = 0; m < 4; ++m)
#pragma unroll
                    for (int bj = 0; bj < 2; ++bj) gt[m][bj] = *(const GAS u32x4*)(P + (size_t)(row0 + ai * 128 + m * 16) * NP + gcol + col0 + bj * 128);
                __builtin_amdgcn_sched_barrier(0);
#pragma unroll
                for (int m = 0; m < 4; ++m)
#pragma unroll
                    for (int bj = 0; bj < 2; ++bj) {
                        const u32x4 g = gt[m][bj]; const f32x4 a0 = bperm_f4(src4, acc[ai][bj][m][0]), a1 = bperm_f4(src4, acc[ai][bj][m][1]);
                        float* gp = G1 + (size_t)(row0 + ai * 128 + m * 16) * DM + col0 + bj * 128;
                        *(GAS f32x4*)gp = (f32x4){a0.x * bflo(g.x), a0.y * bfhi(g.x), a0.z * bflo(g.y), a0.w * bfhi(g.y)};
                        *(GAS f32x4*)(gp + 4) = (f32x4){a1.x * bflo(g.z), a1.y * bfhi(g.z), a1.z * bflo(g.w), a1.w * bfhi(g.w)};
                    }
                __builtin_amdgcn_sched_barrier(0);
            }
        } else {
#pragma unroll
            for (int ai = 0; ai < 2; ++ai)
#pragma unroll
                for (int mp = 0; mp < 2; ++mp) {
                    u32x4 gt[2][2]; f32x4 g1[2][2][2];
#pragma unroll
                    for (int mm = 0; mm < 2; ++mm)
#pragma unroll
                        for (int bj = 0; bj < 2; ++bj) { const int row = row0 + ai * 128 + (2 * mp + mm) * 16, c = col0 + bj * 128;
                            gt[mm][bj] = *(const GAS u32x4*)(P + (size_t)row * NP + gcol + c);
                            g1[mm][bj][0] = *(const GAS f32x4*)(G1 + (size_t)row * DM + c); g1[mm][bj][1] = *(const GAS f32x4*)(G1 + (size_t)row * DM + c + 4); }
                    __builtin_amdgcn_sched_barrier(0);
#pragma unroll
                    for (int mm = 0; mm < 2; ++mm)
#pragma unroll
                        for (int bj = 0; bj < 2; ++bj) { const int m = 2 * mp + mm; const int row = row0 + ai * 128 + m * 16, c = col0 + bj * 128;
                            const u32x4 g = gt[mm][bj]; const f32x4 a0 = bperm_f4(src4, acc[ai][bj][m][0]), a1 = bperm_f4(src4, acc[ai][bj][m][1]), h0 = g1[mm][bj][0], h1 = g1[mm][bj][1];
                            u32x4 w; w.x = pk2(a0.x * bflo(g.x) + h0.x, a0.y * bfhi(g.x) + h0.y); w.y = pk2(a0.z * bflo(g.y) + h0.z, a0.w * bfhi(g.y) + h0.w);
                            w.z = pk2(a1.x * bflo(g.z) + h1.x, a1.y * bfhi(g.z) + h1.y); w.w = pk2(a1.z * bflo(g.w) + h1.z, a1.w * bfhi(g.w) + h1.w);
                            *(GAS u32x4*)(MB + (size_t)row * DM + c) = w; }
                    __builtin_amdgcn_sched_barrier(0);
                }
        }
    }
};
struct BrOrder {
    int G, c;
    __device__ bool next(int i, pg8::Unit& u) const {
        const int p = (i >> 1) * G + c; if (p >= 256) return false;
        const int x = p & 7, q = p >> 3; int pm = 4 * x + (q >> 3), pn = q & 7;
        if (i & 1) { pm += 32; pn += 8; }
        u.pm = pm; u.pn = pn; return true;
    }
    __device__ __forceinline__ void a_ready(const pg8::Unit&) const {}
    __device__ __forceinline__ void done(const pg8::Unit&) const {}
};
struct EpiOut {
    static constexpr bool PERM = true, AFTER_DRAIN = false;
    const float* xold; float* out; bf16* XN; float* RS;
    __device__ __forceinline__ void operator()(const pg8::f32x4 (&acc)[2][2][4][2], const pg8::Unit& u, int wr, int wc, int fr, int fq) const {
        const int src4 = (16 * (fr & 3) + 4 * fq + (fr >> 2)) * 4;
        const int row0 = u.pm * 256 + wr * 64 + 4 * fq + (fr >> 2), col0 = u.pn * 256 + wc * 32 + 8 * (fr & 3);
#pragma unroll
        for (int ai = 0; ai < 2; ++ai) {
            f32x4 xo[4][2][2];
#pragma unroll
            for (int m = 0; m < 4; ++m)
#pragma unroll
                for (int bj = 0; bj < 2; ++bj) { const size_t off = (size_t)(row0 + ai * 128 + m * 16) * DM + col0 + bj * 128; xo[m][bj][0] = *(const GAS f32x4*)(xold + off); xo[m][bj][1] = *(const GAS f32x4*)(xold + off + 4); }
            __builtin_amdgcn_sched_barrier(0);
#pragma unroll
            for (int m = 0; m < 4; ++m) {
                const int row = row0 + ai * 128 + m * 16; float ss = 0.f;
#pragma unroll
                for (int bj = 0; bj < 2; ++bj) {
                    const size_t off = (size_t)row * DM + col0 + bj * 128;
                    const f32x4 x0 = xo[m][bj][0] + bperm_f4(src4, acc[ai][bj][m][0]), x1 = xo[m][bj][1] + bperm_f4(src4, acc[ai][bj][m][1]);
                    *(GAS f32x4*)(out + off) = x0; *(GAS f32x4*)(out + off + 4) = x1;
                    if (XN) { u32x4 w; w.x = pk2(x0.x, x0.y); w.y = pk2(x0.z, x0.w); w.z = pk2(x1.x, x1.y); w.w = pk2(x1.z, x1.w); *(GAS u32x4*)(XN + off) = w;
                        ss += (x0.x * x0.x + x0.y * x0.y) + (x0.z * x0.z + x0.w * x0.w) + (x1.x * x1.x + x1.y * x1.y) + (x1.z * x1.z + x1.w * x1.w); }
                }
                if (XN) { ss += __shfl_xor(ss, 1); ss += __shfl_xor(ss, 2); if ((fr & 3) == 0) ((GAS float*)RS)[(size_t)row * 32 + u.pn * 4 + wc] = ss; }
            }
            __builtin_amdgcn_sched_barrier(0);
        }
    }
};
#define RLX_AGENT __ATOMIC_RELAXED, __HIP_MEMORY_SCOPE_AGENT
#define XB_TMO      128
#define XB_XCNT(j)  (256  + 64 * (j))
#define XB_XSUB(j)  (1280 + 64 * (j))
#define XB_XGEN(j)  (2304 + 64 * (j))
#define XB_TOP      3328
#define XB_TOPGEN   3392
#define XCD_BAR_WORDS 3456
#define XB_SPIN_CAP (1u << 18)

__device__ __forceinline__ unsigned xb_ld(unsigned* p)              { return __hip_atomic_load(p, __ATOMIC_RELAXED, __HIP_MEMORY_SCOPE_AGENT); }
__device__ __forceinline__ unsigned xb_add(unsigned* p, unsigned v) { return __hip_atomic_fetch_add(p, v, __ATOMIC_RELAXED, __HIP_MEMORY_SCOPE_AGENT); }
__device__ __forceinline__ unsigned xb_xcc_id() { return (unsigned)__builtin_amdgcn_s_getreg((3 << 11) | 20) & 0xFu; }
#define XB_SPIN(cond, bar) do { unsigned _sp = 0; while (cond) { __builtin_amdgcn_s_sleep(1); \
    if ((++_sp & 255u) == 0u) { if (xb_ld(&(bar)[XB_TMO])) break; if (_sp > XB_SPIN_CAP) { atomicAdd(&(bar)[XB_TMO], 1u); break; } } } } while (0)

struct XcdBarrier {
    unsigned* bar; unsigned x;
    volatile LAS unsigned* st;
};

__device__ __forceinline__ XcdBarrier xcd_barrier_post(unsigned* bar, volatile LAS unsigned* st) {
    XcdBarrier b; b.bar = bar; b.x = xb_xcc_id(); b.st = st;
    if (threadIdx.x == 0) (void)xb_add(&bar[XB_XCNT(b.x)], 1u);
    return b;
}
__device__ __forceinline__ void xcd_barrier_complete(unsigned* bar, unsigned x, unsigned& nloc, unsigned& nx) {
    const unsigned G = gridDim.x * gridDim.y * gridDim.z;
    unsigned sum, cnt, mine, sp = 0u;
    for (;;) {
        sum = 0u; cnt = 0u; mine = 0u;
#pragma unroll
        for (unsigned j = 0; j < 16; ++j) { const unsigned c = xb_ld(&bar[XB_XCNT(j)]); sum += c; cnt += (c > 0u) ? 1u : 0u; mine = (j == x) ? c : mine; }
        if (sum == G) break;
        __builtin_amdgcn_s_sleep(1);
        if ((++sp & 255u) == 0u) { if (xb_ld(&bar[XB_TMO])) break; if (sp > XB_SPIN_CAP) { atomicAdd(&bar[XB_TMO], 1u); break; } }
    }
    nloc = mine > 0u ? mine : 1u; nx = cnt > 0u ? cnt : 1u;
}

__device__ __forceinline__ void xcd_barrier(const XcdBarrier& b) {
    asm volatile("s_waitcnt vmcnt(0)" ::: "memory");
    __syncthreads();
    if (threadIdx.x == 0) {
        unsigned* bar = b.bar;
        __builtin_amdgcn_s_waitcnt(0);
        unsigned nloc = b.st[0], nx = b.st[1];
        if (nloc == 0u) { xcd_barrier_complete(bar, b.x, nloc, nx); b.st[0] = nloc; b.st[1] = nx; }
        const unsigned old = xb_add(&bar[XB_XSUB(b.x)], 1u);
        const unsigned gen = old / nloc;
        if (old + 1u == (gen + 1u) * nloc) {
            __builtin_amdgcn_fence(__ATOMIC_RELEASE, "agent");
            asm volatile("s_waitcnt vmcnt(0)" ::: "memory");
            const unsigned og = xb_add(&bar[XB_TOP], 1u);
            const unsigned tg = og / nx;
            if (og + 1u == (tg + 1u) * nx) xb_add(&bar[XB_TOPGEN], 1u);
            else XB_SPIN(xb_ld(&bar[XB_TOPGEN]) == tg, bar);
            __builtin_amdgcn_fence(__ATOMIC_ACQUIRE, "agent");
            xb_add(&bar[XB_XGEN(b.x)], 1u);
            asm volatile("s_waitcnt vmcnt(0)" ::: "memory");
        } else {
            XB_SPIN(xb_ld(&bar[XB_XGEN(b.x)]) == gen, bar);
            __builtin_amdgcn_fence(__ATOMIC_ACQUIRE, "agent");
            asm volatile("s_waitcnt vmcnt(0)" ::: "memory");
        }
    }
    __syncthreads();
}
__device__ __forceinline__ void state_unit(LAS unsigned char* lds, const bf16* RQKV, bf16* TS, unsigned* flag, int b, int h, int e, int tid) {
    asm volatile("" : "+s"(RQKV), "+s"(TS), "+s"(flag), "+s"(e), "+v"(tid));
    const int lane = tid & 63, w = __builtin_amdgcn_readfirstlane(tid >> 6), fr = lane & 15, fq = lane >> 4;
    const bf16* RK = RQKV + RQKV_ONE / 2 + (size_t)((b * 8 + h) * 2048) * 256; const bf16* RV = RK + RQKV_ONE / 2;
    bf16* TSb = TS + (size_t)((b * 8 + h) * 8) * 65536;
    constexpr int KB = 64 * 528, VPITCH = 144, VB = 64 * VPITCH, SBUF = KB + VB;
    const float l2g = __log2f(1.f - exp2f(-5.f - (float)h));
    const float c64 = __builtin_amdgcn_exp2f(64.f * l2g);
    f32x4 T[2][4];
#pragma unroll
    for (int i = 0; i < 2; ++i)
#pragma unroll
        for (int j = 0; j < 4; ++j) T[i][j] = (f32x4){0.f, 0.f, 0.f, 0.f};
    const int srow = tid >> 5, sch = tid & 31;
    const size_t soff = (size_t)srow * 256 + sch * 8;
    const int vtok = tid >> 3, vpc = tid & 7;
    const size_t voff = (size_t)vtok * 256 + 64 * e + vpc * 8;
    const float vsc = __builtin_amdgcn_exp2f((float)(63 - vtok) * l2g);
    u32x4 kreg[4][4], vreg[4];
#pragma unroll
    for (int ts = 0; ts < 4; ++ts) {
#pragma unroll
        for (int i = 0; i < 4; ++i) kreg[ts][i] = __builtin_nontemporal_load((const GAS u32x4*)(RK + soff + (size_t)(64 * ts + 16 * i) * 256));
        vreg[ts] = *(const GAS u32x4*)(RV + voff + (size_t)(64 * ts) * 256);
    }
    __syncthreads();
#pragma unroll 1
    for (int tb = 0; tb < 7; ++tb) {
#pragma unroll
        for (int ts = 0; ts < 4; ++ts) {
            const int tt = 4 * tb + ts;
            LAS unsigned char* Ks = lds + (ts & 1) * SBUF; LAS unsigned char* Vs = Ks + KB;
#pragma unroll
            for (int i = 0; i < 4; ++i) *(LAS u32x4*)(Ks + (srow + 16 * i) * 528 + sch * 16) = kreg[ts][i];
            { const u32x4 v = vreg[ts]; u32x4 o; o.x = pk2(bflo(v.x) * vsc, bfhi(v.x) * vsc); o.y = pk2(bflo(v.y) * vsc, bfhi(v.y) * vsc); o.z = pk2(bflo(v.z) * vsc, bfhi(v.z) * vsc); o.w = pk2(bflo(v.w) * vsc, bfhi(v.w) * vsc);
              *(LAS u32x4*)(Vs + vtok * VPITCH + vpc * 16) = o; }
            __syncthreads();
            if (tb < 6) {
#pragma unroll
                for (int i = 0; i < 4; ++i) kreg[ts][i] = __builtin_nontemporal_load((const GAS u32x4*)(RK + soff + (size_t)(64 * (tt + 4) + 16 * i) * 256));
                vreg[ts] = *(const GAS u32x4*)(RV + voff + (size_t)(64 * (tt + 4)) * 256);
            }
#pragma unroll
            for (int i = 0; i < 2; ++i)
#pragma unroll
                for (int j = 0; j < 4; ++j) T[i][j] = T[i][j] * c64;
#pragma unroll
            for (int G = 0; G < 2; ++G) {
                const int trow = 32 * G + 8 * fq + (fr >> 2);
                bf16x8 Af[2], Bf[4];
#pragma unroll
                for (int d = 0; d < 2; ++d) { LAS unsigned char* a1 = Ks + trow * 528 + (16 * (2 * w + d) + 4 * (fr & 3)) * 2; const s16x4 t1 = ldtr(a1), t2 = ldtr(a1 + 4 * 528); Af[d] = __builtin_shufflevector(t1, t2, 0, 1, 2, 3, 4, 5, 6, 7); }
#pragma unroll
                for (int d = 0; d < 4; ++d) { LAS unsigned char* a1 = Vs + trow * VPITCH + (16 * d + 4 * (fr & 3)) * 2; const s16x4 t1 = ldtr(a1), t2 = ldtr(a1 + 4 * VPITCH); Bf[d] = __builtin_shufflevector(t1, t2, 0, 1, 2, 3, 4, 5, 6, 7); }
#pragma unroll
                for (int i = 0; i < 2; ++i)
#pragma unroll
                    for (int j = 0; j < 4; ++j) T[i][j] = mfma16(Af[i], Bf[j], T[i][j]);
            }
            if (ts == 3) {
                GAS bf16* o = (GAS bf16*)(TSb + (size_t)(tb + 1) * 65536);
#pragma unroll
                for (int i = 0; i < 2; ++i)
#pragma unroll
                    for (int j = 0; j < 4; ++j) { u32x2 pk; pk.x = pk2(T[i][j][0], T[i][j][1]); pk.y = pk2(T[i][j][2], T[i][j][3]);
                        *(GAS u32x2*)(o + (size_t)(64 * e + 16 * j + fr) * 256 + 16 * (2 * w + i) + 4 * fq) = pk; }
            }
        }
    }
    asm volatile("s_waitcnt vmcnt(0)" ::: "memory");
    __syncthreads();
    if (tid == 0) {
        __builtin_amdgcn_fence(__ATOMIC_RELEASE, "agent");
        asm volatile("s_waitcnt vmcnt(0)" ::: "memory");
        __hip_atomic_fetch_add((GAS unsigned*)flag, 1u, __ATOMIC_RELAXED, __HIP_MEMORY_SCOPE_AGENT);
    }
}

__device__ __forceinline__ void ret_unit(LAS unsigned char* lds, const bf16* P, const bf16* RQKV, const bf16* TS, unsigned* flag, bf16* ACAT, const float* rog, int b, int h, int qb, int tid) {
    asm volatile("" : "+s"(P), "+s"(RQKV), "+s"(TS), "+s"(flag), "+s"(ACAT), "+s"(rog), "+s"(qb), "+v"(tid));
    const bf16* RQ = RQKV + (size_t)((b * 8 + h) * 2048) * 256; const bf16* RK = RQ + RQKV_ONE / 2; const bf16* RV = RK + RQKV_ONE / 2;
    const int lane = tid & 63, w = __builtin_amdgcn_readfirstlane(tid >> 6), fr = lane & 15, fq = lane >> 4;
    constexpr int BUFB = 64 * 528 + 64 * 544;
    const int qi = 128 * qb + 16 * w + fr;
    const size_t tq = (size_t)(b * SEQ + qi);
    f32x4 O[16];
#pragma unroll
    for (int nb = 0; nb < 16; ++nb) O[nb] = (f32x4){0.f, 0.f, 0.f, 0.f};
    const float l2g = __log2f(1.f - exp2f(-5.f - (float)h));
    const int nkt = 2 * qb + 2;
    const int qc = 2 * qb + (w >> 2);
    const int srow = tid >> 5, sch = tid & 31;
    const size_t soff = (size_t)srow * 256 + sch * 8;
    u32x4 kreg[4], vreg[4];
    const int sc = qb >> 1, m0 = 4 * sc;
    bf16x8 Qf[8];
#pragma unroll
    for (int kk = 0; kk < 8; ++kk) Qf[kk] = *(const GAS bf16x8*)(RQ + (size_t)qi * 256 + 32 * kk + 8 * fq);
    f32x4 ca[4];
    float l2gp = l2g; asm volatile("" : "+v"(l2gp));
    { const float ai = __builtin_amdgcn_exp2f((float)(16 * (w & 3) + fr) * l2gp);
#pragma unroll
      for (int g = 0; g < 4; ++g)
#pragma unroll
          for (int r = 0; r < 4; ++r) ca[g][r] = ai * __builtin_amdgcn_exp2f(-(float)(16 * g + 4 * fq + r) * l2gp); }
#pragma unroll
    for (int i = 0; i < 4; ++i) { const size_t o = soff + (size_t)(64 * m0 + 16 * i) * 256; kreg[i] = __builtin_nontemporal_load((const GAS u32x4*)(RK + o)); vreg[i] = __builtin_nontemporal_load((const GAS u32x4*)(RV + o)); }
#pragma unroll
    for (int i = 0; i < 4; ++i) { *(LAS u32x4*)(lds + (srow + 16 * i) * 528 + sch * 16) = kreg[i]; *(LAS u32x4*)(lds + 64 * 528 + (srow + 16 * i) * 544 + sch * 16) = vreg[i]; }
    __syncthreads();
    for (int m = m0; m < nkt; ++m) {
        LAS unsigned char* Ks = lds + (m & 1) * BUFB; LAS unsigned char* Vs = Ks + 64 * 528;
        if (m + 1 < nkt) {
#pragma unroll
            for (int i = 0; i < 4; ++i) { const size_t o = soff + (size_t)(64 * (m + 1) + 16 * i) * 256; kreg[i] = __builtin_nontemporal_load((const GAS u32x4*)(RK + o)); vreg[i] = __builtin_nontemporal_load((const GAS u32x4*)(RV + o)); }
        }
        if (m <= qc) {
            f32x4 S[4];
#pragma unroll
            for (int g = 0; g < 4; ++g) S[g] = (f32x4){0.f, 0.f, 0.f, 0.f};
            {
                const LAS unsigned char* kb = Ks + fr * 528 + fq * 16;
                bf16x8 Kc[4], Kn[4];
#pragma unroll
                for (int g = 0; g < 4; ++g) Kc[g] = *(const LAS bf16x8*)(kb + g * (16 * 528));
#pragma unroll
                for (int kk = 0; kk < 8; ++kk) {
                    if (kk + 1 < 8) {
#pragma unroll
                        for (int g = 0; g < 4; ++g) Kn[g] = *(const LAS bf16x8*)(kb + g * (16 * 528) + (kk + 1) * 64); }
                    __builtin_amdgcn_sched_barrier(0);
#pragma unroll
                    for (int g = 0; g < 4; ++g) S[g] = mfma16(Kc[g], Qf[kk], S[g]);
                    __builtin_amdgcn_sched_barrier(0);
                    if (kk + 1 < 8) {
#pragma unroll
                        for (int g = 0; g < 4; ++g) Kc[g] = Kn[g]; }
                }
            }
            if (m < qc) {
                const float tm = __builtin_amdgcn_exp2f((float)(64 * (qc - m)) * l2g);
#pragma unroll
                for (int g = 0; g < 4; ++g) S[g] = S[g] * (ca[g] * tm);
            } else {
#pragma unroll
                for (int g = 0; g < 4; ++g)
#pragma unroll
                    for (int r = 0; r < 4; ++r) { const int j = 64 * m + 16 * g + 4 * fq + r; const int d = qi > j ? qi - j : j - qi; S[g][r] *= __builtin_amdgcn_exp2f((float)d * l2g); }
            }
            bf16x8 Pf[2];
#pragma unroll
            for (int G = 0; G < 2; ++G) { u32x4 t; t.x = pk2(S[2 * G][0], S[2 * G][1]); t.y = pk2(S[2 * G][2], S[2 * G][3]); t.z = pk2(S[2 * G + 1][0], S[2 * G + 1][1]); t.w = pk2(S[2 * G + 1][2], S[2 * G + 1][3]); Pf[G] = __builtin_bit_cast(bf16x8, t); }
            {
                const LAS unsigned char* vbse = Vs + (4 * fq + (fr >> 2)) * 544 + (4 * (fr & 3)) * 2;
                s16x4 tc[2][2][2], tn[2][2][2];
#pragma unroll
                for (int u = 0; u < 2; ++u)
#pragma unroll
                    for (int G = 0; G < 2; ++G) { tc[u][G][0] = ldtr((LAS unsigned char*)vbse + 32 * G * 544 + 32 * u); tc[u][G][1] = ldtr((LAS unsigned char*)vbse + (32 * G + 16) * 544 + 32 * u); }
#pragma unroll
                for (int np = 0; np < 8; ++np) {
                    if (np + 1 < 8) {
#pragma unroll
                        for (int u = 0; u < 2; ++u)
#pragma unroll
                            for (int G = 0; G < 2; ++G) { tn[u][G][0] = ldtr((LAS unsigned char*)vbse + 32 * G * 544 + 32 * (2 * (np + 1) + u)); tn[u][G][1] = ldtr((LAS unsigned char*)vbse + (32 * G + 16) * 544 + 32 * (2 * (np + 1) + u)); } }
                    __builtin_amdgcn_sched_barrier(0);
#pragma unroll
                    for (int G = 0; G < 2; ++G)
#pragma unroll
                        for (int u = 0; u < 2; ++u)
                            O[2 * np + u] = mfma16(__builtin_shufflevector(tc[u][G][0], tc[u][G][1], 0, 1, 2, 3, 4, 5, 6, 7), Pf[G], O[2 * np + u]);
                    __builtin_amdgcn_sched_barrier(0);
                    if (np + 1 < 8) {
#pragma unroll
                        for (int u = 0; u < 2; ++u)
#pragma unroll
                            for (int G = 0; G < 2; ++G) { tc[u][G][0] = tn[u][G][0]; tc[u][G][1] = tn[u][G][1]; } }
                }
            }
        }
        if (m + 1 < nkt) {
            LAS unsigned char* Kn = lds + ((m + 1) & 1) * BUFB;
#pragma unroll
            for (int i = 0; i < 4; ++i) { *(LAS u32x4*)(Kn + (srow + 16 * i) * 528 + sch * 16) = kreg[i]; *(LAS u32x4*)(Kn + 64 * 528 + (srow + 16 * i) * 544 + sch * 16) = vreg[i]; }
        }
        __syncthreads();
    }
    if (sc > 0) {
        if (tid == 0) {
            unsigned spins = 0;
            while (__hip_atomic_load((GAS unsigned*)flag, __ATOMIC_RELAXED, __HIP_MEMORY_SCOPE_AGENT) < 4u) { __builtin_amdgcn_s_sleep(2); if (++spins > (1u << 22)) break; }
            __builtin_amdgcn_fence(__ATOMIC_ACQUIRE, "agent");
            asm volatile("s_waitcnt vmcnt(0)" ::: "memory");
        }
        __syncthreads();
        const float ai = __builtin_amdgcn_exp2f((float)(qi - 256 * sc + 1) * l2g);
        bf16x8 Qs[8];
#pragma unroll
        for (int kk = 0; kk < 8; ++kk) { const u32x4 qr = *(const GAS u32x4*)(RQ + (size_t)qi * 256 + 32 * kk + 8 * fq); u32x4 qs;
            qs.x = pk2(bflo(qr.x) * ai, bfhi(qr.x) * ai); qs.y = pk2(bflo(qr.y) * ai, bfhi(qr.y) * ai); qs.z = pk2(bflo(qr.z) * ai, bfhi(qr.z) * ai); qs.w = pk2(bflo(qr.w) * ai, bfhi(qr.w) * ai); Qs[kk] = __builtin_bit_cast(bf16x8, qs); }
        const bf16* TSb = TS + (size_t)(((b * 8 + h) * 8 + sc) * 256) * 256;
#pragma unroll
        for (int i = 0; i < 4; ++i) vreg[i] = *(const GAS u32x4*)(TSb + soff + (size_t)(16 * i) * 256);
#pragma unroll
        for (int td = 0; td < 4; ++td) {
            __syncthreads();
#pragma unroll
            for (int i = 0; i < 4; ++i) *(LAS u32x4*)(lds + (srow + 16 * i) * 528 + sch * 16) = vreg[i];
            __syncthreads();
            if (td + 1 < 4) {
#pragma unroll
                for (int i = 0; i < 4; ++i) vreg[i] = *(const GAS u32x4*)(TSb + soff + (size_t)(64 * (td + 1) + 16 * i) * 256); }
            const LAS unsigned char* tb0 = lds + fr * 528 + fq * 16;
#pragma unroll
            for (int np = 0; np < 2; ++np) {
                bf16x8 Af[2][8];
#pragma unroll
                for (int u = 0; u < 2; ++u)
#pragma unroll
                    for (int kk = 0; kk < 8; ++kk) Af[u][kk] = *(const LAS bf16x8*)(tb0 + (16 * (2 * np + u)) * 528 + kk * 64);
                __builtin_amdgcn_sched_barrier(0);
#pragma unroll
                for (int kk = 0; kk < 8; ++kk)
#pragma unroll
                    for (int u = 0; u < 2; ++u) O[4 * td + 2 * np + u] = mfma16(Af[u][kk], Qs[kk], O[4 * td + 2 * np + u]);
                __builtin_amdgcn_sched_barrier(0);
            }
        }
        __syncthreads();
    }
    float ss = 0.f;
#pragma unroll
    for (int nb = 0; nb < 16; ++nb) ss += (O[nb][0] * O[nb][0] + O[nb][1] * O[nb][1]) + (O[nb][2] * O[nb][2] + O[nb][3] * O[nb][3]);
    ss += __shfl_xor(ss, 16); ss += __shfl_xor(ss, 32);
    const float rn = rsqrtf(ss * (1.f / 256.f) + EPS);
    LAS float* Ot = (LAS float*)(lds + w * 16640);
#pragma unroll
    for (int nb = 0; nb < 16; ++nb) *(LAS f32x4*)(Ot + fr * 260 + 16 * nb + 4 * fq) = O[nb] * rn;
    __builtin_amdgcn_fence(__ATOMIC_RELEASE, "wavefront"); __builtin_amdgcn_wave_barrier();
    {
        const f32x4 gv = *(const GAS f32x4*)(rog + h * 256 + 4 * lane);
        const size_t t0r = (size_t)(b * SEQ + 128 * qb + 16 * w);
        u32x2 sg[16];
#pragma unroll
        for (int i = 0; i < 16; ++i) sg[i] = *(const GAS u32x2*)(P + (t0r + i) * NP + C_RG + h * 256 + 4 * lane);
#pragma unroll
        for (int i = 0; i < 16; ++i) {
            const f32x4 o4 = *(const LAS f32x4*)(Ot + i * 260 + 4 * lane);
            u32x2 o; o.x = pk2(o4.x * gv.x * bflo(sg[i].x), o4.y * gv.y * bfhi(sg[i].x)); o.y = pk2(o4.z * gv.z * bflo(sg[i].y), o4.w * gv.w * bfhi(sg[i].y));
            *(GAS u32x2*)(ACAT + (t0r + i) * DM + h * 256 + 4 * lane) = o;
        }
    }
    __syncthreads();
}

typedef unsigned u32x2v __attribute__((ext_vector_type(2)));
__device__ __forceinline__ float half_sum32(float a, float b, float& hi_out) {
    const u32x2v r = __builtin_amdgcn_permlane32_swap(__float_as_uint(a), __float_as_uint(b), false, false);
    (void)hi_out; return __uint_as_float(r.x) + __uint_as_float(r.y);
}
__device__ __forceinline__ void topk_list(const unsigned (&uk)[32], LAS int* list, LAS float* listr, LAS unsigned* listT, const GAS f32x4* sak, int lane) {
    unsigned T = 0u;
    for (int bit = 31; bit >= 0; --bit) {
        const unsigned cand = T | (1u << bit);
        int c = 0;
#pragma unroll
        for (int rr = 0; rr < 32; ++rr) c += __builtin_popcountll(__builtin_amdgcn_ballot_w64(uk[rr] >= cand));
        if (c >= 256) T = cand;
        if (c == 256) break;
    }
    int cgt = 0;
#pragma unroll
    for (int rr = 0; rr < 32; ++rr) cgt += __builtin_popcountll(__builtin_amdgcn_ballot_w64(uk[rr] > T));
    const int need_eq = 256 - cgt;
    int base = 0, eqseen = 0;
#pragma unroll
    for (int rr = 0; rr < 32; ++rr) {
        const bool gt = uk[rr] > T, eq = uk[rr] == T;
        const unsigned long long meq = __builtin_amdgcn_ballot_w64(eq);
        const int erank = eqseen + (int)__builtin_amdgcn_mbcnt_hi((unsigned)(meq >> 32), __builtin_amdgcn_mbcnt_lo((unsigned)meq, 0u));
        const bool sel = gt || (eq && erank < need_eq);
        const unsigned long long ms = __builtin_amdgcn_ballot_w64(sel);
        const int pos = base + (int)__builtin_amdgcn_mbcnt_hi((unsigned)(ms >> 32), __builtin_amdgcn_mbcnt_lo((unsigned)ms, 0u));
        if (sel) { list[pos] = 64 * rr + lane; listT[((pos >> 5) * 4 + (pos & 3)) * 8 + ((pos >> 2) & 7)] = (unsigned)(64 * rr + lane) * 512u; }
        base += __builtin_popcountll(ms); eqseen += __builtin_popcountll(meq);
    }
}

__device__ __forceinline__ void att_core(LAS unsigned char* Vst, const LAS float* listr, const LAS unsigned* listT, const bf16* P, const bf16* AKVb, bf16* ACAT, const float* aqg, size_t tok, int cnt, int lane) {
    const int fr = lane & 15, fq = lane >> 4;
    const GAS unsigned char* kbase = (const GAS unsigned char*)AKVb + fr * 16;
    const LAS unsigned* lt = listT + fq * 8;
    u32x4 kb[3][8];
#pragma unroll
    for (int s2 = 0; s2 < 3; ++s2) {
        const u32x4 o0 = *(const LAS u32x4*)(lt + s2 * 32), o1 = *(const LAS u32x4*)(lt + s2 * 32 + 4);
#pragma unroll
        for (int i = 0; i < 8; ++i) kb[s2][i] = *(const GAS u32x4*)(kbase + (i < 4 ? o0[i & 3] : o1[i & 3]));
    }
    bf16x8 Qf[4];
    {
        u32x4 raw[4]; float ss = 0.f;
#pragma unroll
        for (int kk = 0; kk < 4; ++kk) { raw[kk] = *(const GAS u32x4*)(P + tok * NP + C_AQ + fr * 128 + 32 * kk + 8 * fq);
#pragma unroll
            for (int e = 0; e < 4; ++e) { const float lo = bflo(raw[kk][e]), hi = bfhi(raw[kk][e]); ss += lo * lo + hi * hi; } }
        ss += __shfl_xor(ss, 16); ss += __shfl_xor(ss, 32);
        const float rq = rsqrtf(ss * (1.f / 128.f) + EPS) * (0.08838834764831845f * LOG2E);
#pragma unroll
        for (int kk = 0; kk < 4; ++kk) { const f32x4 g0 = *(const GAS f32x4*)(aqg + 32 * kk + 8 * fq), g1 = *(const GAS f32x4*)(aqg + 32 * kk + 8 * fq + 4); u32x4 o;
            o.x = pk2(bflo(raw[kk].x) * rq * g0.x, bfhi(raw[kk].x) * rq * g0.y); o.y = pk2(bflo(raw[kk].y) * rq * g0.z, bfhi(raw[kk].y) * rq * g0.w);
            o.z = pk2(bflo(raw[kk].z) * rq * g1.x, bfhi(raw[kk].z) * rq * g1.y); o.w = pk2(bflo(raw[kk].w) * rq * g1.z, bfhi(raw[kk].w) * rq * g1.w);
            Qf[kk] = __builtin_bit_cast(bf16x8, o); }
    }
    f32x4 lg[16];
    float mx = -INFINITY;
#pragma unroll
    for (int st = 0; st < 8; ++st) {
#pragma unroll
        for (int i = 0; i < 8; ++i) *(LAS u32x4*)(Vst + (4 * i + fq) * 272 + fr * 16) = kb[st % 3][i];
        __builtin_amdgcn_fence(__ATOMIC_RELEASE, "wavefront"); __builtin_amdgcn_wave_barrier();
        bf16x8 Kf[2][4];
#pragma unroll
        for (int gg = 0; gg < 2; ++gg)
#pragma unroll
            for (int kk = 0; kk < 4; ++kk) Kf[gg][kk] = *(const LAS bf16x8*)(Vst + (16 * gg + fr) * 272 + kk * 64 + fq * 16);
        const f32x4 lr0 = *(const LAS f32x4*)(listr + 32 * st + 4 * fq), lr1 = *(const LAS f32x4*)(listr + 32 * st + 16 + 4 * fq);
        if (st + 3 < 8) {
            const u32x4 o0 = *(const LAS u32x4*)(lt + (st + 3) * 32), o1 = *(const LAS u32x4*)(lt + (st + 3) * 32 + 4);
#pragma unroll
            for (int i = 0; i < 8; ++i) kb[st % 3][i] = *(const GAS u32x4*)(kbase + (i < 4 ? o0[i & 3] : o1[i & 3]));
        }
        __builtin_amdgcn_sched_barrier(0);
#pragma unroll
        for (int gg = 0; gg < 2; ++gg) {
            const int g = 2 * st + gg;
            f32x4 a = (f32x4){0.f, 0.f, 0.f, 0.f};
#pragma unroll
            for (int kk = 0; kk < 4; ++kk) a = mfma16(Kf[gg][kk], Qf[kk], a);
            const f32x4 lr = gg ? lr1 : lr0;
#pragma unroll
            for (int r = 0; r < 4; ++r) lg[g][r] = (16 * g + 4 * fq + r < cnt) ? a[r] * lr[r] : -INFINITY;
            mx = fmaxf(mx, fmaxf(fmaxf(lg[g][0], lg[g][1]), fmaxf(lg[g][2], lg[g][3])));
        }
        __builtin_amdgcn_fence(__ATOMIC_RELEASE, "wavefront"); __builtin_amdgcn_wave_barrier();
        __builtin_amdgcn_sched_barrier(0);
    }
    u32x4 vb[3][8];
#pragma unroll
    for (int s2 = 0; s2 < 3; ++s2) {
        const u32x4 o0 = *(const LAS u32x4*)(lt + s2 * 32), o1 = *(const LAS u32x4*)(lt + s2 * 32 + 4);
#pragma unroll
        for (int i = 0; i < 8; ++i) vb[s2][i] = *(const GAS u32x4*)(kbase + 256 + (i < 4 ? o0[i & 3] : o1[i & 3]));
    }
    mx = fmaxf(mx, __shfl_xor(mx, 16)); mx = fmaxf(mx, __shfl_xor(mx, 32));
    float sum = 0.f;
#pragma unroll
    for (int g = 0; g < 16; ++g)
#pragma unroll
        for (int r = 0; r < 4; ++r) { const float pz = __builtin_amdgcn_exp2f(lg[g][r] - mx); lg[g][r] = pz; sum += pz; }
    sum += __shfl_xor(sum, 16); sum += __shfl_xor(sum, 32);
    bf16x8 Pf[8];
#pragma unroll
    for (int G = 0; G < 8; ++G) { u32x4 t; t.x = pk2(lg[2 * G][0], lg[2 * G][1]); t.y = pk2(lg[2 * G][2], lg[2 * G][3]); t.z = pk2(lg[2 * G + 1][0], lg[2 * G + 1][1]); t.w = pk2(lg[2 * G + 1][2], lg[2 * G + 1][3]); Pf[G] = __builtin_bit_cast(bf16x8, t); }
    f32x4 O[8];
#pragma unroll
    for (int nb = 0; nb < 8; ++nb) O[nb] = (f32x4){0.f, 0.f, 0.f, 0.f};
    const LAS unsigned char* vbse = Vst + (4 * fq + (fr >> 2)) * 288 + (4 * (fr & 3)) * 2;
#pragma unroll
    for (int G = 0; G < 8; ++G) {
#pragma unroll
        for (int i = 0; i < 8; ++i) *(LAS u32x4*)(Vst + (4 * i + fq) * 288 + fr * 16) = vb[G % 3][i];
        __builtin_amdgcn_fence(__ATOMIC_RELEASE, "wavefront"); __builtin_amdgcn_wave_barrier();
        s16x4 tc[2][2], tn[2][2];
#pragma unroll
        for (int u = 0; u < 2; ++u) { tc[u][0] = ldtr((LAS unsigned char*)vbse + 32 * u); tc[u][1] = ldtr((LAS unsigned char*)vbse + 16 * 288 + 32 * u); }
        if (G + 3 < 8) {
            const u32x4 o0 = *(const LAS u32x4*)(lt + (G + 3) * 32), o1 = *(const LAS u32x4*)(lt + (G + 3) * 32 + 4);
#pragma unroll
            for (int i = 0; i < 8; ++i) vb[G % 3][i] = *(const GAS u32x4*)(kbase + 256 + (i < 4 ? o0[i & 3] : o1[i & 3]));
        }
#pragma unroll
        for (int np = 0; np < 4; ++np) {
            if (np + 1 < 4) {
#pragma unroll
                for (int u = 0; u < 2; ++u) { tn[u][0] = ldtr((LAS unsigned char*)vbse + 32 * (2 * (np + 1) + u)); tn[u][1] = ldtr((LAS unsigned char*)vbse + 16 * 288 + 32 * (2 * (np + 1) + u)); } }
            __builtin_amdgcn_sched_barrier(0);
#pragma unroll
            for (int u = 0; u < 2; ++u) O[2 * np + u] = mfma16(__builtin_shufflevector(tc[u][0], tc[u][1], 0, 1, 2, 3, 4, 5, 6, 7), Pf[G], O[2 * np + u]);
            __builtin_amdgcn_sched_barrier(0);
            if (np + 1 < 4) {
#pragma unroll
                for (int u = 0; u < 2; ++u) { tc[u][0] = tn[u][0]; tc[u][1] = tn[u][1]; } }
        }
        __builtin_amdgcn_fence(__ATOMIC_RELEASE, "wavefront"); __builtin_amdgcn_wave_barrier();
        __builtin_amdgcn_sched_barrier(0);
    }
    const float rs = __builtin_amdgcn_rcpf(sum);
    LAS float* Ot = (LAS float*)Vst;
#pragma unroll
    for (int nb = 0; nb < 8; ++nb) *(LAS f32x4*)(Ot + fr * 132 + 16 * nb + 4 * fq) = O[nb] * rs;
    __builtin_amdgcn_fence(__ATOMIC_RELEASE, "wavefront"); __builtin_amdgcn_wave_barrier();
    {
        u32x2 sg[8];
#pragma unroll
        for (int j = 0; j < 8; ++j) sg[j] = *(const GAS u32x2*)(P + tok * NP + C_AG + 256 * j + 4 * lane);
#pragma unroll
        for (int j = 0; j < 8; ++j) {
            const int c = 256 * j + 4 * lane;
            const f32x4 o4 = *(const LAS f32x4*)(Ot + (c >> 7) * 132 + (c & 127));
            u32x2 o; o.x = pk2(o4.x * bflo(sg[j].x), o4.y * bfhi(sg[j].x)); o.y = pk2(o4.z * bflo(sg[j].y), o4.w * bfhi(sg[j].y));
            *(GAS u32x2*)(ACAT + ((size_t)NTOK + tok) * DM + c) = o;
        }
    }
    __builtin_amdgcn_fence(__ATOMIC_RELEASE, "wavefront"); __builtin_amdgcn_wave_barrier();
}

__device__ __forceinline__ void att_unit(LAS unsigned char* lds, const bf16* P, const bf16* AKV, const bf16* IKC, bf16* ACAT, const float* aqg, const float* ssq_ak, const float* ssq_ik, int b, int qg, int tid) {
    asm volatile("" : "+s"(P), "+s"(AKV), "+s"(IKC), "+s"(ACAT), "+s"(aqg), "+s"(ssq_ak), "+s"(ssq_ik), "+s"(qg), "+v"(tid));
    const int lane = tid & 63, w = __builtin_amdgcn_readfirstlane(tid >> 6), fr = lane & 15, fq = lane >> 4;
    LAS unsigned char* IK = lds;
    LAS unsigned char* Vst = lds + w * 9216;
    LAS int* list0 = (LAS int*)(lds + 73728 + w * 6144);
    const int L = 64 * ((qg >> 2) + 1);
    const bf16* AKVb = AKV + (size_t)(b * SEQ) * 256;
    const bf16* IKb = IKC + (size_t)(b * SEQ) * 128;
    const GAS f32x4* sak = (const GAS f32x4*)ssq_ak + b * SEQ;
    const size_t tok0 = (size_t)(b * SEQ + 16 * qg + 2 * w);
    int cnt;
    if (L <= 256) {
        cnt = L;
#pragma unroll
        for (int r = 0; r < 4; ++r) { const int i = 64 * r + lane; const int kx = i < L ? i : 0; const f32x4 q4 = sak[kx]; const float rk = rsqrtf(((q4.x + q4.y) + (q4.z + q4.w)) * (1.f / 128.f) + EPS);
            list0[i] = kx; ((LAS float*)list0)[256 + i] = rk; list0[512 + i] = kx; ((LAS float*)list0)[768 + i] = rk;
            const int tp = ((i >> 5) * 4 + (i & 3)) * 8 + ((i >> 2) & 7); ((LAS unsigned*)list0)[1024 + tp] = (unsigned)kx * 512u; ((LAS unsigned*)list0)[1280 + tp] = (unsigned)kx * 512u; }
    } else {
        cnt = 256;
        typedef float f32x2 __attribute__((ext_vector_type(2)));
        const GAS f32x2* sik = (const GAS f32x2*)ssq_ik + b * SEQ;
        bf16x8 Qi[2][2]; float wv[2][4];
#pragma unroll
        for (int q = 0; q < 2; ++q) {
#pragma unroll
            for (int kk = 0; kk < 2; ++kk) Qi[q][kk] = *(const GAS bf16x8*)(P + (tok0 + q) * NP + C_IQ + fr * 64 + 32 * kk + 8 * fq);
            const u32x2 ww = *(const GAS u32x2*)(IKC + (tok0 + q) * 128 + 64 + 4 * fq); wv[q][0] = bflo(ww.x); wv[q][1] = bfhi(ww.x); wv[q][2] = bflo(ww.y); wv[q][3] = bfhi(ww.y);
        }
        unsigned uk[2][32];
        const int ntile = (L + 255) >> 8;
        const int skey = tid >> 3, spart = tid & 7;
        const bf16* sb = IKb + (size_t)skey * 128 + spart * 8;
        u32x4 ikr[4]; f32x2 rik[4];
#pragma unroll
        for (int i = 0; i < 4; ++i) { ikr[i] = *(const GAS u32x4*)(sb + (size_t)(64 * i) * 128); rik[i] = sik[64 * i + lane]; }
#pragma unroll
        for (int i = 0; i < 4; ++i) *(LAS u32x4*)(IK + (skey + 64 * i) * 144 + spart * 16) = ikr[i];
        __syncthreads();
#pragma unroll
        for (int tile = 0; tile < 8; ++tile) {
            if (tile < ntile) {
                LAS unsigned char* IKc = IK + (tile & 1) * 36864;
                f32x2 rc[4];
#pragma unroll
                for (int i = 0; i < 4; ++i) rc[i] = rik[i];
                if (tile + 1 < ntile) {
#pragma unroll
                    for (int i = 0; i < 4; ++i) { ikr[i] = *(const GAS u32x4*)(sb + (size_t)(256 * (tile + 1) + 64 * i) * 128); rik[i] = sik[256 * (tile + 1) + 64 * i + lane]; }
                }
#pragma unroll
                for (int r4 = 0; r4 < 4; ++r4) {
                    float pt[2][4];
#pragma unroll
                    for (int q4 = 0; q4 < 4; ++q4) {
                        const LAS unsigned char* kp = IKc + (64 * r4 + 16 * q4 + fr) * 144 + fq * 16;
                        const bf16x8 K0 = *(const LAS bf16x8*)kp, K1 = *(const LAS bf16x8*)(kp + 64);
#pragma unroll
                        for (int q = 0; q < 2; ++q) {
                            f32x4 a = (f32x4){0.f, 0.f, 0.f, 0.f};
                            a = mfma16(Qi[q][0], K0, a); a = mfma16(Qi[q][1], K1, a);
                            pt[q][q4] = fmaxf(a[0], 0.f) * wv[q][0] + fmaxf(a[1], 0.f) * wv[q][1] + fmaxf(a[2], 0.f) * wv[q][2] + fmaxf(a[3], 0.f) * wv[q][3];
                        }
                    }
                    const int rr = 4 * tile + r4;
                    const float rscale = rsqrtf((rc[r4].x + rc[r4].y) * (1.f / 64.f) + EPS);
                    const bool live = 64 * rr + lane < L;
#pragma unroll
                    for (int q = 0; q < 2; ++q) {
                        float hx; const float A = half_sum32(pt[q][0], pt[q][2], hx), B = half_sum32(pt[q][1], pt[q][3], hx);
                        const bool odd = fq & 1;
                        const float send = odd ? A : B, keep = odd ? B : A;
                        const float sc = live ? (keep + __shfl_xor(send, 16)) * rscale : -INFINITY;
                        const unsigned bts = __float_as_uint(sc);
                        uk[q][rr] = bts ^ ((unsigned)((int)bts >> 31) | 0x80000000u);
                    }
                }
                if (tile + 1 < ntile) {
#pragma unroll
                    for (int i = 0; i < 4; ++i) *(LAS u32x4*)(IK + ((tile + 1) & 1) * 36864 + (skey + 64 * i) * 144 + spart * 16) = ikr[i];
                }
                __syncthreads();
            } else {
#pragma unroll
                for (int r4 = 0; r4 < 4; ++r4) { uk[0][4 * tile + r4] = 0x007fffffu; uk[1][4 * tile + r4] = 0x007fffffu; }
            }
        }
        topk_list(uk[0], list0, (LAS float*)list0 + 256, (LAS unsigned*)list0 + 1024, sak, lane);
        topk_list(uk[1], list0 + 512, (LAS float*)list0 + 768, (LAS unsigned*)list0 + 1280, sak, lane);
        __builtin_amdgcn_fence(__ATOMIC_RELEASE, "wavefront"); __builtin_amdgcn_wave_barrier();
        f32x4 q4[2][4];
#pragma unroll
        for (int q = 0; q < 2; ++q)
#pragma unroll
            for (int i = 0; i < 4; ++i) q4[q][i] = sak[list0[512 * q + 64 * i + lane]];
#pragma unroll
        for (int q = 0; q < 2; ++q)
#pragma unroll
            for (int i = 0; i < 4; ++i) ((LAS float*)list0)[512 * q + 256 + 64 * i + lane] = rsqrtf(((q4[q][i].x + q4[q][i].y) + (q4[q][i].z + q4[q][i].w)) * (1.f / 128.f) + EPS);
    }
    __syncthreads();
#pragma unroll 1
#ifndef REP_ATTB
#define REP_ATTB 1
#endif
    for (int q = 0; q < 2 * REP_ATTB; ++q)
        att_core(Vst, (const LAS float*)list0 + 512 * (q & 1) + 256, (const LAS unsigned*)list0 + 1024 + 256 * (q & 1), P, AKVb, ACAT, aqg, tok0 + (q & 1), cnt, lane);
}


struct Params { const float* in[10]; float* out; unsigned char* ws; };

__global__ void __launch_bounds__(512, 2) mega_fwd(Params p) {
    extern __shared__ __attribute__((aligned(16))) unsigned char lds_raw[];
    LAS unsigned char* lds = (LAS unsigned char*)lds_raw;
    cg::grid_group grid = cg::this_grid();
    const int tid = threadIdx.x, lane = tid & 63, wave = __builtin_amdgcn_readfirstlane(tid >> 6);
    const int G = gridDim.x, bx = blockIdx.x;
    const int gw = bx * 8 + wave, NGW = G * 8;
    unsigned char* ws = p.ws;
    if (tid < 8) ((LAS unsigned*)(lds + LDS_WQ_OFF))[16 + tid] = 0u;
    __syncthreads();
    (void)xcd_barrier_post((unsigned*)(ws + CTL_XBAR), (volatile LAS unsigned*)(lds + LDS_WQ_OFF + 64));
    grid.sync();
#ifdef REP_BAR
#define GSYNC() do { _Pragma("unroll 1") for (int rb_ = 0; rb_ < 2; ++rb_) GSYNC1(); } while (0)
#else
#define GSYNC() GSYNC1()
#endif
#define GSYNC1() do { unsigned char* wsb = p.ws; asm volatile("" : "+s"(wsb)); XcdBarrier xb_; xb_.bar = (unsigned*)(wsb + CTL_XBAR); xb_.x = xb_xcc_id(); xb_.st = (volatile LAS unsigned*)(lds + LDS_WQ_OFF + 64); xcd_barrier(xb_); } while (0)
#define LAUNDER() unsigned char* wsl = ws; asm volatile("" : "+s"(wsl)); bf16* XN = (bf16*)(wsl + WS_XN); bf16* Pm = (bf16*)(wsl + WS_P); bf16* ACAT = (bf16*)(wsl + WS_ACAT); float* G1 = (float*)(wsl + WS_G1); bf16* MB = (bf16*)(wsl + WS_MB); \
    const float* cosT = (const float*)(wsl + WS_TAB); const float* sinT = cosT + 2048 * 128; float* ssq_ak = (float*)(wsl + WS_SSQ); float* ssq_ik = ssq_ak + (size_t)NTOK * 4; bf16* AKV = (bf16*)(wsl + WS_AKV); bf16* IKC = (bf16*)(wsl + WS_IKC); bf16* RQKV = (bf16*)(wsl + WS_RQKV); (void)AKV; (void)IKC; (void)RQKV; \
    (void)XN; (void)Pm; (void)ACAT; (void)G1; (void)MB; (void)cosT; (void)sinT; (void)ssq_ak; (void)ssq_ik;

#ifndef PH
#define PH 31
#endif
#if PH & 1
#ifndef REP_P0
#define REP_P0 1
#endif
#pragma unroll 1
    for (int r0 = 0; r0 < REP_P0; ++r0) { __syncthreads(); p0_phase(p.in, ws, lds, gw, NGW, wave, lane, bx * 512 + tid, G * 512); }
#endif
    GSYNC();

    for (int l = 0; l < DEPTH; ++l) {
#if PH & 2
        {
            LAUNDER();
            pg8::Gemm g{XN, (const bf16*)(wsl + WS_WIN + l * WIN_L), NTOK, NP, DM};
            pg8::StaticOrder S; S.init(NTOK, NP, G, bx);
            int rbase;
            { pg8::Unit u0; int pmin = 1 << 30, pmax = -1; for (int i = 0; S.next(i, u0); ++i) { pmin = u0.pm < pmin ? u0.pm : pmin; pmax = u0.pm > pmax ? u0.pm : pmax; }
              if (pmax < 0) { pmin = 0; pmax = 0; }
              rbase = pmin * 256; const int nrw = (pmax - pmin + 1) * 256 < 2048 ? (pmax - pmin + 1) * 256 : 2048;
              LAS float* rt = (LAS float*)(lds + LDS_RTAB_OFF); const GAS f32x4* RSv = (const GAS f32x4*)(wsl + WS_RS);
              int tidl = tid; asm volatile("" : "+v"(tidl));
#pragma unroll 1
              for (int j = 0; j < 4; ++j) { const int rrow = tidl + 512 * j; if (rrow >= nrw) break; const GAS f32x4* rp = RSv + (size_t)(rbase + rrow) * 8; float sm = 0.f;
#pragma unroll
                  for (int e = 0; e < 8; ++e) { const f32x4 t4 = rp[e]; sm += (t4.x + t4.y) + (t4.z + t4.w); }
                  rt[rrow] = rsqrtf(sm * (1.f / DM) + EPS); }
              __syncthreads(); }
            EpiP E{Pm, cosT, sinT, p.in[5] + l * 128, p.in[6] + l * 64, ssq_ak, ssq_ik, AKV, IKC, RQKV, (const LAS float*)(lds + LDS_RTAB_OFF), rbase};
#ifndef REP_GEMM
#define REP_GEMM 1
#endif
#pragma unroll 1
            for (int rg = 0; rg < REP_GEMM; ++rg) { __syncthreads(); pg8::gemm_phase<EpiP, pg8::StaticOrder, true, true>(lds, g, S, E); }
            if (l + 1 < DEPTH) { int tidc = tid; asm volatile("" : "+v"(tidc)); conv_drain(p.in, wsl, lds, l + 1, tidc); }
        }
#endif
        GSYNC();
#if PH & 4
        {
            LAUNDER();
#ifndef REP_P2
#define REP_P2 1
#endif
            LAS int* wq = (LAS int*)(lds + LDS_WQ_OFF);
            const float* rog = p.in[3] + l * 2048; const float* aqg = p.in[4] + l * 128;
            const int hb = (int)((xb_xcc_id() >> 1) & 3u);
#pragma unroll 1
            for (int sb = 0; sb < 4; ++sb) {
                const int b = (hb + sb) & 3;
                unsigned* ctr = (unsigned*)(wsl + CTL_WQ + 1024 * l + 256 * b);
                const bf16* TS = (const bf16*)(wsl + WS_TS);
                for (;;) {
                    __syncthreads();
                    if (tid == 0) wq[0] = (int)atomicAdd(ctr, 1u);
                    __syncthreads();
                    const int u = __builtin_amdgcn_readfirstlane(wq[0]);
                    if (u >= 288) break;
                    int kind, a0 = 0, a1 = 0;
                    if (u < 32) { kind = 0; a0 = u >> 2; a1 = u & 3; }
                    else if (u < 160) { kind = 1; a0 = 127 - (u - 32); }
                    else { const int k = u - 160; kind = 2; a0 = k & 7; a1 = 15 - (k >> 3); }
                    unsigned* flagp = (unsigned*)(wsl + CTL_FLAG) + ((l * 4 + b) * 8 + a0) * 16;
                    if (kind == 1) {
#ifndef NO_ATT
                        att_unit(lds, Pm, AKV, IKC, ACAT, aqg, ssq_ak, ssq_ik, b, a0, tid);
#endif
                    } else if (kind == 2) {
#ifndef NO_RET
                        ret_unit(lds, Pm, RQKV, TS, flagp, ACAT, rog, b, a0, a1, tid);
#endif
                    } else {
                        state_unit(lds, RQKV, (bf16*)TS, flagp, b, a0, a1, tid);
                    }
                }
            }
        }
#endif
        GSYNC();
#if PH & 8
        {
            LAUNDER();
            pg8::Gemm g{ACAT, (const bf16*)(wsl + WS_WBR + l * WBR_L), 2 * NTOK, 4096, DM};
            BrOrder S{G, bx};
            EpiBr E{Pm, G1, MB};
#pragma unroll 1
            for (int rg = 0; rg < REP_GEMM; ++rg) { __syncthreads(); pg8::gemm_phase<EpiBr, BrOrder, true, true>(lds, g, S, E); }
        }
#endif
        GSYNC();
#if PH & 16
        {
            LAUNDER();
            pg8::Gemm g{MB, (const bf16*)(wsl + WS_WOUT + l * WOUT_L), NTOK, DM, DM};
            pg8::StaticOrder S; S.init(NTOK, DM, G, bx);
            float* outl = p.out; const float* xol = l == 0 ? p.in[0] : (const float*)p.out; asm volatile("" : "+s"(outl), "+s"(xol));
            EpiOut E{xol, outl, l + 1 < DEPTH ? XN : (bf16*)nullptr, (float*)(wsl + WS_RS)};
            pg8::gemm_phase<EpiOut, pg8::StaticOrder, true, true>(lds, g, S, E);
        }
#endif
        if (l + 1 < DEPTH) GSYNC();
    }
}

extern "C" void kernel_launch(void* const* d_in, const int* in_sizes, int n_in, void* d_out, int out_size, void* d_ws, size_t ws_size, hipStream_t stream) {
    static int grid = 0;
    if (grid == 0) {
        if (n_in != 10 || out_size != NTOK * DM || ws_size < WS_END) { fprintf(stderr, "kernel_launch: unexpected shapes (n_in %d out %d ws %zu need %zu)\n", n_in, out_size, ws_size, (size_t)WS_END); grid = -1; return; }
        int dev = 0, cus = 0, per_cu = 0;
        hipGetDevice(&dev);
        hipDeviceGetAttribute(&cus, hipDeviceAttributeMultiprocessorCount, dev);
        if (hipFuncSetAttribute((const void*)mega_fwd, hipFuncAttributeMaxDynamicSharedMemorySize, LDS_BYTES) != hipSuccess) { fprintf(stderr, "kernel_launch: hipFuncSetAttribute failed\n"); grid = -1; return; }
        if (hipOccupancyMaxActiveBlocksPerMultiprocessor(&per_cu, (const void*)mega_fwd, 512, LDS_BYTES) != hipSuccess || per_cu < 1) { fprintf(stderr, "kernel_launch: occupancy query gave %d\n", per_cu); per_cu = 1; }
        (void)hipGetLastError();
        grid = cus * per_cu;
    }
    if (grid < 0) return;
    hipMemsetAsync((char*)d_ws + WS_CTL, 0, CTL_BYTES, stream);
    Params p{};
    for (int i = 0; i < 10; ++i) p.in[i] = (const float*)d_in[i];
    p.out = (float*)d_out; p.ws = (unsigned char*)d_ws;
    void* args[] = {&p};
    hipError_t e = hipLaunchCooperativeKernel((const void*)mega_fwd, dim3(grid), dim3(512), args, LDS_BYTES, stream);
    if (e != hipSuccess) fprintf(stderr, "cooperative launch failed: %s (grid %d)\n", hipGetErrorString(e), grid);
}
```
